# Optimizing an MI355X kernel written in HIP

```python
import jax, jax.numpy as jnp
from jax import lax
import numpy as np

D_MODEL = 1024
BATCH = 8
SEQ = 2048
DEPTH = 1

GRID_W = 64
CTX_LEN = 256
D_POOL = 1024
POOL_GROUPS = 4
POOL_WINDOWS = (2, 4, 8, 16)
POOL_GW = D_POOL // POOL_GROUPS
D_LRU = 1024
LRU_BLOCKS = 8
LRU_BW = D_LRU // LRU_BLOCKS
LRU_CONV_W = 4
LRU_C = 8.0
D_FF = 3 * D_MODEL
FFN_CONV_W = 3
N_MOD = 6
EPS = 1e-6
D_IN = D_POOL + 2 * D_LRU + 2 * D_MODEL
SPLITS = (D_POOL, D_POOL + D_LRU, D_POOL + 2 * D_LRU, D_POOL + 2 * D_LRU + D_MODEL)

kernel_name = 'hybrid_pool_rglru_convffn_dit_block'


def rmsnorm(x, g):
    xf = x.astype(jnp.float32)
    y = xf * lax.rsqrt(jnp.mean(xf * xf, axis=-1, keepdims=True) + EPS)
    return (y * g.astype(jnp.float32)).astype(x.dtype)


def modulation(cond, w_mod, b_mod):
    m = jax.nn.silu(cond) @ w_mod + b_mod
    return jnp.split(m[..., None, :], N_MOD, axis=-1)


def window_bounds(n, w):
    pos = jnp.arange(n)
    return jnp.clip(pos - w // 2, 0, n), jnp.clip(pos + w - w // 2, 0, n)


def multiscale_pool_minus_identity(u):
    B, R, W, C = u.shape
    uf = u.astype(jnp.float32)
    s = jnp.cumsum(jnp.cumsum(uf, axis=1), axis=2)
    s = jnp.pad(s, ((0, 0), (1, 0), (1, 0), (0, 0)))
    outs = []
    for gi, w in enumerate(POOL_WINDOWS):
        sg = s[..., gi * POOL_GW:(gi + 1) * POOL_GW]
        r_lo, r_hi = window_bounds(R, w)
        c_lo, c_hi = window_bounds(W, w)
        total = (sg[:, r_hi][:, :, c_hi] - sg[:, r_lo][:, :, c_hi]
                 - sg[:, r_hi][:, :, c_lo] + sg[:, r_lo][:, :, c_lo])
        cnt = ((r_hi - r_lo)[:, None] * (c_hi - c_lo)[None, :]).astype(jnp.float32)
        outs.append(total / cnt[None, :, :, None])
    pooled = jnp.concatenate(outs, axis=-1)
    return (pooled - uf).astype(u.dtype)


def pool_mixer(u, pool_w, pool_scale):
    B, R, W, C = u.shape
    d = multiscale_pool_minus_identity(u).reshape(B, R * W, POOL_GROUPS, POOL_GW)
    y = jnp.einsum('blgc,gcd->blgd', d, pool_w).reshape(B, R * W, C)
    return y * pool_scale


def centred_dwconv1d(u, w, b):
    K = w.shape[0]
    L = u.shape[1]
    left = K // 2
    up = jnp.pad(u, ((0, 0), (left, K - 1 - left), (0, 0)))
    acc = b + up[:, 0:L] * w[0]
    for k in range(1, K):
        acc = acc + up[:, k:k + L] * w[k]
    return acc


def rglru_coeffs(xc, w_a, b_a, w_x, b_x, lam):
    B, L, C = xc.shape
    xb = xc.reshape(B, L, LRU_BLOCKS, LRU_BW)
    r = jax.nn.sigmoid((jnp.einsum('blnc,ncd->blnd', xb, w_a).reshape(B, L, C) + b_a).astype(jnp.float32))
    i = jax.nn.sigmoid((jnp.einsum('blnc,ncd->blnd', xb, w_x).reshape(B, L, C) + b_x).astype(jnp.float32))
    log_a = -LRU_C * r * jax.nn.softplus(-lam.astype(jnp.float32))
    a = jnp.exp(log_a)
    mult = jnp.sqrt(-jnp.expm1(2.0 * log_a))
    return a, mult * i * xc.astype(jnp.float32)


def linear_scan(a, b, h0):
    b = b.at[:, 0].add(a[:, 0] * h0)

    def combine(left, right):
        a_l, b_l = left
        a_r, b_r = right
        return a_l * a_r, a_r * b_l + b_r

    _, h = lax.associative_scan(combine, (a, b), axis=1)
    return h


def project_and_scan(h, p, h0_f, h0_b):
    z = h @ p['w_in']
    u_pool, u_lru, u_gate, g_pool, g_lru = jnp.split(z, SPLITS, axis=-1)
    xc = centred_dwconv1d(u_lru, p['lru_conv_w'], p['lru_conv_b'])
    a_f, b_f = rglru_coeffs(xc, p['lru_wa'][0], p['lru_ba'][0], p['lru_wx'][0], p['lru_bx'][0], p['lru_lambda'][0])
    a_b, b_b = rglru_coeffs(xc, p['lru_wa'][1], p['lru_ba'][1], p['lru_wx'][1], p['lru_bx'][1], p['lru_lambda'][1])
    h_f = linear_scan(a_f, b_f, h0_f)
    h_b = jnp.flip(linear_scan(jnp.flip(a_b, 1), jnp.flip(b_b, 1), h0_b), 1)
    return (u_pool, u_gate, g_pool, g_lru), h_f, h_b


def finish_mixer(parts, h_f, h_b, rows, cols, p):
    u_pool, u_gate, g_pool, g_lru = parts
    B, L, _ = u_pool.shape
    y_pool = pool_mixer(u_pool.reshape(B, rows, cols, D_POOL), p['pool_w'], p['pool_scale'])
    y_lru = ((h_f + h_b) * jax.nn.gelu(u_gate.astype(jnp.float32))).astype(u_pool.dtype)
    m = (jax.nn.sigmoid(g_pool) * (y_pool @ p['w_proj_pool'])
         + jax.nn.sigmoid(g_lru) * (y_lru @ p['w_proj_lru']))
    return m @ p['w_out']


def conv_ffn(h, rows, cols, p):
    B, L, _ = h.shape
    g, u = jnp.split(h @ p['w_up'], 2, axis=-1)
    g = lax.conv_general_dilated(g.reshape(B, rows, cols, D_FF), p['ffn_conv_w'], (1, 1), 'SAME',
                                 dimension_numbers=('NHWC', 'HWIO', 'NHWC'),
                                 feature_group_count=D_FF).reshape(B, L, D_FF) + p['ffn_conv_b']
    return (jax.nn.gelu(g) * u) @ p['w_down']


def setup_inputs(seed: int = 0) -> dict:
    key = jax.random.key(seed)
    ks = jax.random.split(key, 32)
    f32 = jnp.float32

    def nrm(k, shape, scale):
        return jax.random.normal(k, shape, f32) * scale

    p_lam = jax.random.uniform(ks[19], (DEPTH, 2, D_LRU), f32, 0.9, 0.999)
    return {
        'x': nrm(ks[0], (BATCH, SEQ, D_MODEL), 1.0),
        'c': nrm(ks[1], (BATCH, D_MODEL), 1.0),
        'ctx': nrm(ks[2], (BATCH, CTX_LEN, D_MODEL), 1.0),
        'c_ctx': nrm(ks[3], (D_MODEL,), 1.0),
        'w_mod': nrm(ks[4], (DEPTH, D_MODEL, N_MOD * D_MODEL), D_MODEL ** -0.5),
        'b_mod': nrm(ks[5], (DEPTH, N_MOD * D_MODEL), 0.01),
        'g_pre_mix': 1.0 + nrm(ks[6], (DEPTH, D_MODEL), 0.05),
        'g_post_mix': 1.0 + nrm(ks[7], (DEPTH, D_MODEL), 0.05),
        'g_pre_ffn': 1.0 + nrm(ks[8], (DEPTH, D_MODEL), 0.05),
        'g_post_ffn': 1.0 + nrm(ks[9], (DEPTH, D_MODEL), 0.05),
        'w_in': nrm(ks[10], (DEPTH, D_MODEL, D_IN), D_MODEL ** -0.5),
        'pool_w': nrm(ks[11], (DEPTH, POOL_GROUPS, POOL_GW, POOL_GW), POOL_GW ** -0.5),
        'pool_scale': 1.0 + nrm(ks[12], (DEPTH, D_POOL), 0.1),
        'lru_conv_w': nrm(ks[13], (DEPTH, LRU_CONV_W, D_LRU), LRU_CONV_W ** -0.5),
        'lru_conv_b': nrm(ks[14], (DEPTH, D_LRU), 0.01),
        'lru_wa': nrm(ks[15], (DEPTH, 2, LRU_BLOCKS, LRU_BW, LRU_BW), LRU_BW ** -0.5),
        'lru_ba': nrm(ks[16], (DEPTH, 2, D_LRU), 0.01),
        'lru_wx': nrm(ks[17], (DEPTH, 2, LRU_BLOCKS, LRU_BW, LRU_BW), LRU_BW ** -0.5),
        'lru_bx': nrm(ks[18], (DEPTH, 2, D_LRU), 0.01),
        'lru_lambda': jnp.log(p_lam) - jnp.log1p(-p_lam),
        'w_proj_pool': nrm(ks[20], (DEPTH, D_POOL, D_MODEL), D_POOL ** -0.5),
        'w_proj_lru': nrm(ks[21], (DEPTH, D_LRU, D_MODEL), D_LRU ** -0.5),
        'w_out': nrm(ks[22], (DEPTH, D_MODEL, D_MODEL), D_MODEL ** -0.5),
        'w_up': nrm(ks[23], (DEPTH, D_MODEL, 2 * D_FF), D_MODEL ** -0.5),
        'ffn_conv_w': nrm(ks[24], (DEPTH, FFN_CONV_W, FFN_CONV_W, 1, D_FF), 1.0 / FFN_CONV_W),
        'ffn_conv_b': nrm(ks[25], (DEPTH, D_FF), 0.01),
        'w_down': nrm(ks[26], (DEPTH, D_FF, D_MODEL), D_FF ** -0.5),
    }


def reference(x, c, ctx, c_ctx, w_mod, b_mod, g_pre_mix, g_post_mix, g_pre_ffn, g_post_ffn,
              w_in, pool_w, pool_scale, lru_conv_w, lru_conv_b, lru_wa, lru_ba, lru_wx, lru_bx,
              lru_lambda, w_proj_pool, w_proj_lru, w_out, w_up, ffn_conv_w, ffn_conv_b, w_down):
    B, L, _ = x.shape
    rows = L // GRID_W
    ctx_len = ctx.shape[1]
    zeros_state = jnp.zeros((B, D_LRU), jnp.float32)
    for i in range(DEPTH):
        p = {
            'w_in': w_in[i], 'pool_w': pool_w[i], 'pool_scale': pool_scale[i],
            'lru_conv_w': lru_conv_w[i], 'lru_conv_b': lru_conv_b[i],
            'lru_wa': lru_wa[i], 'lru_ba': lru_ba[i], 'lru_wx': lru_wx[i], 'lru_bx': lru_bx[i],
            'lru_lambda': lru_lambda[i], 'w_proj_pool': w_proj_pool[i], 'w_proj_lru': w_proj_lru[i],
            'w_out': w_out[i], 'w_up': w_up[i], 'ffn_conv_w': ffn_conv_w[i],
            'ffn_conv_b': ffn_conv_b[i], 'w_down': w_down[i],
        }
        last = i == DEPTH - 1
        sh1_x, sc1_x, ga1_x, sh2_x, sc2_x, ga2_x = modulation(c, w_mod[i], b_mod[i])
        sh1_c, sc1_c, ga1_c, sh2_c, sc2_c, ga2_c = modulation(c_ctx, w_mod[i], b_mod[i])

        hc = rmsnorm(ctx, g_pre_mix[i]) * (1.0 + sc1_c) + sh1_c
        parts_c, hf_c, hb_c = project_and_scan(hc, p, zeros_state, zeros_state)

        hx = rmsnorm(x, g_pre_mix[i]) * (1.0 + sc1_x) + sh1_x
        parts_x, hf_x, hb_x = project_and_scan(hx, p, hf_c[:, -1], hb_c[:, 0])
        mix_x = finish_mixer(parts_x, hf_x, hb_x, rows, GRID_W, p)
        x = x + ga1_x * rmsnorm(mix_x, g_post_mix[i])
        fx = conv_ffn(rmsnorm(x, g_pre_ffn[i]) * (1.0 + sc2_x) + sh2_x, rows, GRID_W, p)
        x = x + ga2_x * rmsnorm(fx, g_post_ffn[i])

        if not last:
            mix_c = finish_mixer(parts_c, hf_c, hb_c, 1, ctx_len, p)
            ctx = ctx + ga1_c * rmsnorm(mix_c, g_post_mix[i])
            fc = conv_ffn(rmsnorm(ctx, g_pre_ffn[i]) * (1.0 + sc2_c) + sh2_c, 1, ctx_len, p)
            ctx = ctx + ga2_c * rmsnorm(fc, g_post_ffn[i])
    return x
```

```cpp
#include <hip/hip_runtime.h>
#include <hip/hip_cooperative_groups.h>
#include <cstdio>
#include <cstdint>
namespace cg = cooperative_groups;

#ifndef MK_ONE
#define MK_ONE 1
#endif

#ifndef MK_REP
#define MK_REP 0
#endif
#define LAS __attribute__((address_space(3)))
typedef unsigned short bf16_t;
typedef short bf16x8 __attribute__((ext_vector_type(8)));
typedef float f32x4 __attribute__((ext_vector_type(4)));
typedef float f32x2 __attribute__((ext_vector_type(2)));
typedef float f32x16 __attribute__((ext_vector_type(16)));
typedef unsigned u32x4 __attribute__((ext_vector_type(4)));
typedef unsigned u32x2 __attribute__((ext_vector_type(2)));

constexpr int D = 1024, NB = 8, SEQL = 2048, M = NB * SEQL, CTXL = 256, MC = NB * CTXL, MT = M + MC, DIN = 5120, DFF = 3072;
constexpr int NCHUNK = 18;
constexpr float EPS = 1e-6f;

constexpr size_t MiB = 1u << 20;
constexpr size_t WS_MOD = MiB / 2;
constexpr size_t WS_WC = 1 * MiB;
constexpr size_t WS_WUP = 2 * MiB;
constexpr size_t WS_WDOWN = 14 * MiB;
constexpr size_t WS_WIN = 20 * MiB;
constexpr size_t WS_WPP = 30 * MiB;
constexpr size_t WS_WLP = 32 * MiB;
constexpr size_t WS_WOUT = 34 * MiB;
constexpr size_t WS_SUM = 36 * MiB;
constexpr size_t WS_HX = 40 * MiB;
constexpr size_t WS_DP = 40 * MiB;
constexpr size_t WS_UPOOL = 76 * MiB;
constexpr size_t WS_YLRU = 76 * MiB;
constexpr size_t WS_ULRU = 108 * MiB;
constexpr size_t WS_GG = 144 * MiB;
constexpr size_t WS_T1M = 144 * MiB;
constexpr size_t WS_SGP = 176 * MiB;
constexpr size_t WS_SGL = 208 * MiB;
constexpr size_t WS_MIX = 176 * MiB;
constexpr size_t WS_H2 = 20 * MiB;
constexpr size_t WS_G = 52 * MiB;
constexpr size_t WS_U = 148 * MiB;
constexpr size_t WS_FX = 52 * MiB;
constexpr size_t WS_CTXP = 240 * MiB;
constexpr size_t WS_END = 256 * MiB;

constexpr int LDS_BYTES = 147456;
constexpr int NPHASE = 12;

__device__ __forceinline__ unsigned cvt_pk_bf16(float lo, float hi) { unsigned r; asm volatile("v_cvt_pk_bf16_f32 %0, %1, %2" : "=v"(r) : "v"(lo), "v"(hi)); return r; }
__device__ __forceinline__ float bf_lo(unsigned u) { return __builtin_bit_cast(float, u << 16); }
__device__ __forceinline__ float bf_hi(unsigned u) { return __builtin_bit_cast(float, u & 0xffff0000u); }
__device__ __forceinline__ float bf2f(bf16_t v) { return __builtin_bit_cast(float, ((unsigned)v) << 16); }
__device__ __forceinline__ float sigmoid_f(float x) { return __builtin_amdgcn_rcpf(1.f + __builtin_amdgcn_exp2f(-1.4426950409f * x)); }
__device__ __forceinline__ float gelu_f(float x) { const float y = x * (1.5957691216f + 0.0713548163f * x * x); return x * __builtin_amdgcn_rcpf(1.f + __builtin_amdgcn_exp2f(-1.4426950409f * y)); }
__device__ __forceinline__ float wave_sum(float v) {
#pragma unroll
    for (int o = 1; o < 64; o <<= 1) v += __shfl_xor(v, o);
    return v;
}
#define LDS_WAIT() asm volatile("s_waitcnt lgkmcnt(0)" ::: "memory")

namespace pg8 {
constexpr int BM = 256, BK = 64, HALF = 128, HTB = HALF * BK * 2, STAGE_BYTES = 8 * HTB, NXCD = 8, WGM = 8;
__host__ __device__ __forceinline__ int lds_byte(int r, int c) { const int st = (r >> 4) * 2 + (c >> 5), rr = r & 15, cc = c & 31, ob = rr * 64 + cc * 2; return st * 1024 + (ob ^ (((ob >> 9) & 1) << 5)); }
__host__ __device__ __forceinline__ void stage_rc(int b, int& R, int& C) { const int st = b / 1024, sb = b % 1024, swz = sb ^ (((sb >> 9) & 1) << 5); R = (st >> 1) * 16 + swz / 64; C = (st & 1) * 32 + (swz % 64) / 2; }
__host__ __device__ __forceinline__ int perm32(int rho) { const int n = rho >> 4, i = rho & 15; return 8 * (i >> 2) + 4 * n + (i & 3); }

struct Unit { int pm, pn, kt0, nt; };
struct Gemm { const bf16_t* A; const bf16_t* Bt; int M, N, K; };

__device__ __forceinline__ void tile_map(int wgid, int nM, int nN, Unit& u) {
    const int nwg = nM * nN;
    { const int q = nwg / NXCD, r = nwg % NXCD, xcd = wgid % NXCD, off = wgid / NXCD; wgid = (xcd < r ? xcd * (q + 1) : r * (q + 1) + (xcd - r) * q) + off; }
    const int nig = WGM * nN, gid = wgid / nig, fm = gid * WGM, gsz = (nM - fm) < WGM ? (nM - fm) : WGM;
    u.pm = fm + ((wgid % nig) % gsz); u.pn = (wgid % nig) / gsz;
}
struct StaticOrder {
    int nM, nN, nwg, G, c, ntk;
    __device__ void init(int M_, int N_, int G_, int c_, int K_) { nM = M_ / BM; nN = N_ / BM; nwg = nM * nN; G = G_; c = c_; ntk = K_ / BK; }
    __device__ bool next(int i, Unit& u) const {
        const long L = (long)i * G + c; if (L >= nwg) return false;
        tile_map((int)L, nM, nN, u); u.kt0 = 0; u.nt = ntk; return true;
    }
    __device__ __forceinline__ void a_ready(const Unit&) const {}
    __device__ __forceinline__ void done(const Unit&) const {}
};
struct Order1 {
    int G, c;
    __device__ bool next(int i, Unit& u) const {
        const long L = (long)i * G + c; if (L >= 1280 + 128) return false;
        if (L < 1280) { tile_map((int)L, 64, 20, u); u.kt0 = 0; u.nt = 16; }
        else { const int q = (int)L - 1280, cu = q >> 2; u.pm = 64 + (cu >> 2); u.pn = 4 + (cu & 3); u.kt0 = 4 * (q & 3); u.nt = 4; }
        return true;
    }
    __device__ __forceinline__ void a_ready(const Unit&) const {}
    __device__ __forceinline__ void done(const Unit&) const {}
};

typedef f32x4 Acc[2][2][4][2];

template <class Epi, class Sched, bool ALIGN_EPI = false, bool SP2 = false>
__device__ __forceinline__ void gemm_phase(LAS unsigned char* lds, const Gemm g, const Sched& S, const Epi& E) {
    const int tid = threadIdx.x, wid = __builtin_amdgcn_readfirstlane(tid >> 6), lane = tid & 63, wr = wid >> 2, wc = wid & 3, fr = lane & 15, fq = lane >> 4;
    const int K = g.K;
    unsigned voffA[2], voffB[2];
#pragma unroll
    for (int i = 0; i < 2; ++i) { int R, C; stage_rc(tid * 16 + i * 8192, R, C); const int Rb = Epi::PERM ? ((R & ~31) + perm32(R & 31)) : R;
        voffA[i] = (unsigned)(R * K + C) * 2u; voffB[i] = (unsigned)(Rb * K + C) * 2u; }
    const size_t kstep = (size_t)(BK * 2);
    const size_t hstep = (size_t)HALF * K * 2;
    const size_t tstep = 2 * hstep;
    const unsigned ldsw = (unsigned)wid * 1024u;
    const int aoff = lds_byte(wr * 64 + fr, fq * 8), boff = lds_byte(wc * 32 + fr, fq * 8);
#define PG8_SA(b, h) (((b) * 2 + (h)) * HTB)
#define PG8_SB(b, h) ((4 + (b) * 2 + (h)) * HTB)
#define PG8_STAGE(bufoff, gbase, voff) do { _Pragma("unroll") for (int _i = 0; _i < 2; ++_i) \
        __builtin_amdgcn_global_load_lds((const unsigned*)((const char*)(gbase) + (voff)[_i]), (LAS unsigned*)(lds + (bufoff) + ldsw + _i * 8192), 16, 0, 0); } while (0)
#define PG8_LDA(dst, b, h) do { _Pragma("unroll") for (int m = 0; m < 4; ++m) _Pragma("unroll") for (int k = 0; k < 2; ++k) dst[m][k] = *(const LAS bf16x8*)(lds + PG8_SA(b, h) + aoff + m * 2048 + k * 1024); } while (0)
#define PG8_LDB(dst, b, h) do { _Pragma("unroll") for (int n = 0; n < 2; ++n) _Pragma("unroll") for (int k = 0; k < 2; ++k) dst[n][k] = *(const LAS bf16x8*)(lds + PG8_SB(b, h) + boff + n * 2048 + k * 1024); } while (0)
#define PG8_MMA(ai, bj, At, Bt) do { __builtin_amdgcn_s_setprio(1); _Pragma("unroll") for (int m = 0; m < 4; ++m) _Pragma("unroll") for (int n = 0; n < 2; ++n) _Pragma("unroll") for (int k = 0; k < 2; ++k) \
        acc[ai][bj][m][n] = __builtin_amdgcn_mfma_f32_16x16x32_bf16(Bt[n][k], At[m][k], acc[ai][bj][m][n], 0, 0, 0); __builtin_amdgcn_s_setprio(0); } while (0)
#define PG8_WAIT_V(n) asm volatile("s_waitcnt vmcnt(" #n ")" ::: "memory")
#define PG8_WAIT_L(n) asm volatile("s_waitcnt lgkmcnt(" #n ")" ::: "memory")
#define PG8_BAR __builtin_amdgcn_s_barrier()
#define PG8_SCHED __builtin_amdgcn_sched_barrier(0)
    Unit cur, nxt; int ui = 0;
    if (!S.next(0, cur)) return;
    f32x4 acc[2][2][4][2];
#pragma unroll
    for (int a = 0; a < 2; ++a)
#pragma unroll
        for (int b = 0; b < 2; ++b)
#pragma unroll
            for (int m = 0; m < 4; ++m)
#pragma unroll
                for (int n = 0; n < 2; ++n) acc[a][b][m][n] = (f32x4){0.f, 0.f, 0.f, 0.f};
    bf16x8 At[4][2], B0[2][2], B1[2][2];
    const char* cA = (const char*)g.A + (size_t)cur.pm * tstep + (size_t)cur.kt0 * kstep; const char* cB = (const char*)g.Bt + (size_t)cur.pn * tstep + (size_t)cur.kt0 * kstep;
    S.a_ready(cur);
    if constexpr (SP2) {
        PG8_STAGE(PG8_SB(0, 0), cB, voffB); PG8_STAGE(PG8_SB(0, 1), cB + hstep, voffB); PG8_STAGE(PG8_SA(0, 0), cA, voffA); PG8_STAGE(PG8_SA(0, 1), cA + hstep, voffA);
        if (wr == 1) PG8_BAR;
        PG8_WAIT_V(2); PG8_BAR;
        PG8_STAGE(PG8_SB(1, 0), cB + kstep, voffB); PG8_STAGE(PG8_SA(1, 0), cA + kstep, voffA); PG8_STAGE(PG8_SB(1, 1), cB + hstep + kstep, voffB);
        PG8_WAIT_V(6); PG8_BAR;
    } else {
        PG8_STAGE(PG8_SB(0, 0), cB, voffB); PG8_STAGE(PG8_SA(0, 0), cA, voffA); PG8_STAGE(PG8_SB(0, 1), cB + hstep, voffB); PG8_STAGE(PG8_SA(0, 1), cA + hstep, voffA);
        if (wr == 1) PG8_BAR;
        PG8_WAIT_V(4); PG8_BAR;
        PG8_STAGE(PG8_SB(1, 0), cB + kstep, voffB); PG8_STAGE(PG8_SA(1, 0), cA + kstep, voffA); PG8_STAGE(PG8_SB(1, 1), cB + hstep + kstep, voffB);
        PG8_WAIT_V(6); PG8_BAR;
    }
    for (;;) {
        const bool has_next = S.next(ui + 1, nxt);
        const char* nA = has_next ? (const char*)g.A + (size_t)nxt.pm * tstep + (size_t)nxt.kt0 * kstep : cA; const char* nB = has_next ? (const char*)g.Bt + (size_t)nxt.pn * tstep + (size_t)nxt.kt0 * kstep : cB;
        const int nt = cur.nt;
        for (int t = 0; t < nt; t += 2) {
            const bool last = (t == nt - 2);
            const char* a1 = cA + (size_t)(t + 1) * kstep;
            const char* a2 = last ? nA : cA + (size_t)(t + 2) * kstep; const char* b2 = last ? nB : cB + (size_t)(t + 2) * kstep;
            const char* a3 = a2 + kstep; const char* b3 = b2 + kstep;
            if (last && has_next) S.a_ready(nxt);
            if constexpr (SP2) {
            PG8_LDB(B0, 0, 0); PG8_LDB(B1, 0, 1); PG8_SCHED; PG8_LDA(At, 0, 0); PG8_STAGE(PG8_SA(1, 1), a1 + hstep, voffA);
            PG8_WAIT_V(8); PG8_WAIT_L(0); PG8_BAR; PG8_MMA(0, 0, At, B0); PG8_MMA(0, 1, At, B1); PG8_BAR; PG8_SCHED;
            PG8_LDA(At, 0, 1); PG8_STAGE(PG8_SB(0, 0), b2, voffB); PG8_STAGE(PG8_SB(0, 1), b2 + hstep, voffB); PG8_STAGE(PG8_SA(0, 0), a2, voffA);
            PG8_WAIT_V(8); PG8_WAIT_L(0); PG8_BAR; PG8_MMA(1, 0, At, B0); PG8_MMA(1, 1, At, B1); PG8_BAR; PG8_SCHED;
            PG8_LDB(B0, 1, 0); PG8_LDB(B1, 1, 1); PG8_SCHED; PG8_LDA(At, 1, 0); PG8_STAGE(PG8_SA(0, 1), a2 + hstep, voffA);
            PG8_WAIT_V(8); PG8_WAIT_L(0); PG8_BAR; PG8_MMA(0, 0, At, B0); PG8_MMA(0, 1, At, B1); PG8_BAR; PG8_SCHED;
            PG8_LDA(At, 1, 1); PG8_STAGE(PG8_SB(1, 0), b3, voffB); PG8_STAGE(PG8_SB(1, 1), b3 + hstep, voffB); PG8_STAGE(PG8_SA(1, 0), a3, voffA);
            PG8_WAIT_V(8); PG8_WAIT_L(0); PG8_BAR; PG8_MMA(1, 0, At, B0); PG8_MMA(1, 1, At, B1); PG8_BAR; PG8_SCHED;
            } else {
            PG8_LDB(B0, 0, 0); PG8_SCHED; PG8_LDA(At, 0, 0); PG8_STAGE(PG8_SA(1, 1), a1 + hstep, voffA);
            PG8_WAIT_L(8); PG8_BAR; PG8_WAIT_L(0); PG8_MMA(0, 0, At, B0); PG8_BAR; PG8_SCHED;
            PG8_LDB(B1, 0, 1); PG8_STAGE(PG8_SB(0, 0), b2, voffB);
            PG8_BAR; PG8_WAIT_L(0); PG8_MMA(0, 1, At, B1); PG8_BAR;
            PG8_LDA(At, 0, 1); PG8_STAGE(PG8_SA(0, 0), a2, voffA);
            PG8_BAR; PG8_WAIT_L(0); PG8_MMA(1, 0, At, B0); PG8_BAR; PG8_SCHED;
            PG8_STAGE(PG8_SB(0, 1), b2 + hstep, voffB);
            PG8_WAIT_V(6); PG8_BAR; PG8_MMA(1, 1, At, B1); PG8_BAR;
            PG8_LDB(B0, 1, 0); PG8_SCHED; PG8_LDA(At, 1, 0); PG8_STAGE(PG8_SA(0, 1), a2 + hstep, voffA);
            PG8_WAIT_L(8); PG8_BAR; PG8_WAIT_L(0); PG8_MMA(0, 0, At, B0); PG8_BAR; PG8_SCHED;
            PG8_LDB(B1, 1, 1); PG8_STAGE(PG8_SB(1, 0), b3, voffB);
            PG8_BAR; PG8_WAIT_L(0); PG8_MMA(0, 1, At, B1); PG8_BAR;
            PG8_LDA(At, 1, 1); PG8_STAGE(PG8_SA(1, 0), a3, voffA);
            PG8_BAR; PG8_WAIT_L(0); PG8_MMA(1, 0, At, B0); PG8_BAR; PG8_SCHED;
            PG8_STAGE(PG8_SB(1, 1), b3 + hstep, voffB);
            PG8_WAIT_V(6); PG8_BAR; PG8_MMA(1, 1, At, B1); PG8_BAR;
            }
        }
        if constexpr (ALIGN_EPI) { if (wr == 0) PG8_BAR; }
        E(acc, cur, wr, wc, fr, fq); S.done(cur);
        if (!has_next) break;
#pragma unroll
        for (int a = 0; a < 2; ++a)
#pragma unroll
            for (int b = 0; b < 2; ++b)
#pragma unroll
                for (int m = 0; m < 4; ++m)
#pragma unroll
                    for (int n = 0; n < 2; ++n) acc[a][b][m][n] = (f32x4){0.f, 0.f, 0.f, 0.f};
        cur = nxt; cA = nA; cB = nB; ++ui;
        if constexpr (ALIGN_EPI) { if (wr == 1) PG8_BAR; }
    }
    PG8_WAIT_V(0);
    if constexpr (!ALIGN_EPI) { if (wr == 0) PG8_BAR; }
    PG8_BAR;
#undef PG8_SA
#undef PG8_SB
#undef PG8_STAGE
#undef PG8_LDA
#undef PG8_LDB
#undef PG8_MMA
#undef PG8_WAIT_V
#undef PG8_WAIT_L
#undef PG8_BAR
#undef PG8_SCHED
}

struct Epi1 {
    static constexpr bool PERM = true;
    bf16_t *upool, *ulru, *gg, *sgp, *sgl, *ctxp;
    __device__ __forceinline__ void operator()(const Acc& acc, const Unit& u, int wr, int wc, int fr, int fq) const {
        const bool isctx = u.pm >= 64;
        const int sec = u.pn >> 2;
        bf16_t* base = isctx ? ctxp + (size_t)(u.kt0 >> 2) * MC * D : (sec == 0 ? upool : sec == 1 ? ulru : sec == 2 ? gg : sec == 3 ? sgp : sgl);
        const int row0 = (isctx ? u.pm - 64 : u.pm) * BM + wr * 64 + fr, col0 = (u.pn & 3) * BM + wc * 32 + 8 * fq;
#pragma unroll
        for (int ai = 0; ai < 2; ++ai)
#pragma unroll
            for (int m = 0; m < 4; ++m) { bf16_t* rowp = base + (size_t)(row0 + ai * HALF + m * 16) * D + col0;
#pragma unroll
                for (int bj = 0; bj < 2; ++bj) { f32x4 v0 = acc[ai][bj][m][0], v1 = acc[ai][bj][m][1];
                    if (sec == 2) {
#pragma unroll
                        for (int e = 0; e < 4; ++e) { v0[e] = gelu_f(v0[e]); v1[e] = gelu_f(v1[e]); }
                    } else if (sec >= 3) {
#pragma unroll
                        for (int e = 0; e < 4; ++e) { v0[e] = sigmoid_f(v0[e]); v1[e] = sigmoid_f(v1[e]); }
                    }
                    u32x4 o; o.x = cvt_pk_bf16(v0[0], v0[1]); o.y = cvt_pk_bf16(v0[2], v0[3]); o.z = cvt_pk_bf16(v1[0], v1[1]); o.w = cvt_pk_bf16(v1[2], v1[3]);
                    *(u32x4*)(rowp + bj * HALF) = o; } }
    }
};
template <bool SECOND> struct Epi2 {
    static constexpr bool PERM = true;
    const bf16_t* gate; bf16_t* t1m;
    __device__ __forceinline__ void operator()(const Acc& acc, const Unit& u, int wr, int wc, int fr, int fq) const {
        const int row0 = u.pm * BM + wr * 64 + fr, col0 = u.pn * BM + wc * 32 + 8 * fq;
#pragma unroll
        for (int ai = 0; ai < 2; ++ai)
#pragma unroll
            for (int m = 0; m < 4; ++m) { const size_t off = (size_t)(row0 + ai * HALF + m * 16) * D + col0;
#pragma unroll
                for (int bj = 0; bj < 2; ++bj) { const f32x4 v0 = acc[ai][bj][m][0], v1 = acc[ai][bj][m][1];
                    const u32x4 gt = *(const u32x4*)(gate + off + bj * HALF);
                    float r[8];
                    r[0] = bf_lo(gt.x) * v0[0]; r[1] = bf_hi(gt.x) * v0[1]; r[2] = bf_lo(gt.y) * v0[2]; r[3] = bf_hi(gt.y) * v0[3];
                    r[4] = bf_lo(gt.z) * v1[0]; r[5] = bf_hi(gt.z) * v1[1]; r[6] = bf_lo(gt.w) * v1[2]; r[7] = bf_hi(gt.w) * v1[3];
                    if (SECOND) { const u32x4 t = *(const u32x4*)(t1m + off + bj * HALF);
                        r[0] += bf_lo(t.x); r[1] += bf_hi(t.x); r[2] += bf_lo(t.y); r[3] += bf_hi(t.y); r[4] += bf_lo(t.z); r[5] += bf_hi(t.z); r[6] += bf_lo(t.w); r[7] += bf_hi(t.w); }
                    u32x4 o; o.x = cvt_pk_bf16(r[0], r[1]); o.y = cvt_pk_bf16(r[2], r[3]); o.z = cvt_pk_bf16(r[4], r[5]); o.w = cvt_pk_bf16(r[6], r[7]);
                    *(u32x4*)(t1m + off + bj * HALF) = o; } }
    }
};
struct EpiF32 {
    static constexpr bool PERM = false;
    float* C; int ldc;
    __device__ __forceinline__ void operator()(const Acc& acc, const Unit& u, int wr, int wc, int fr, int fq) const {
        const int row0 = u.pm * BM + wr * 64 + fr, col0 = u.pn * BM + wc * 32 + 4 * fq;
#pragma unroll
        for (int ai = 0; ai < 2; ++ai)
#pragma unroll
            for (int m = 0; m < 4; ++m) { float* rowp = C + (size_t)(row0 + ai * HALF + m * 16) * ldc + col0;
#pragma unroll
                for (int bj = 0; bj < 2; ++bj)
#pragma unroll
                    for (int n = 0; n < 2; ++n) *(f32x4*)(rowp + bj * HALF + n * 16) = acc[ai][bj][m][n]; }
    }
};
struct EpiBf16 {
    static constexpr bool PERM = true;
    bf16_t* C; int ldc;
    __device__ __forceinline__ void operator()(const Acc& acc, const Unit& u, int wr, int wc, int fr, int fq) const {
        const int row0 = u.pm * BM + wr * 64 + fr, col0 = u.pn * BM + wc * 32 + 8 * fq;
#pragma unroll
        for (int ai = 0; ai < 2; ++ai)
#pragma unroll
            for (int m = 0; m < 4; ++m) { bf16_t* rowp = C + (size_t)(row0 + ai * HALF + m * 16) * ldc + col0;
#pragma unroll
                for (int bj = 0; bj < 2; ++bj) { const f32x4 v0 = acc[ai][bj][m][0], v1 = acc[ai][bj][m][1];
                    u32x4 o; o.x = cvt_pk_bf16(v0[0], v0[1]); o.y = cvt_pk_bf16(v0[2], v0[3]); o.z = cvt_pk_bf16(v1[0], v1[1]); o.w = cvt_pk_bf16(v1[2], v1[3]);
                    *(u32x4*)(rowp + bj * HALF) = o; } }
    }
};
struct Epi4 {
    static constexpr bool PERM = true;
    bf16_t *g, *u;
    __device__ __forceinline__ void operator()(const Acc& acc, const Unit& un, int wr, int wc, int fr, int fq) const {
        bf16_t* base = un.pn < 12 ? g : u; const int pn = un.pn < 12 ? un.pn : un.pn - 12;
        const int row0 = un.pm * BM + wr * 64 + fr, col0 = pn * BM + wc * 32 + 8 * fq;
#pragma unroll
        for (int ai = 0; ai < 2; ++ai)
#pragma unroll
            for (int m = 0; m < 4; ++m) { bf16_t* rowp = base + (size_t)(row0 + ai * HALF + m * 16) * DFF + col0;
#pragma unroll
                for (int bj = 0; bj < 2; ++bj) { const f32x4 v0 = acc[ai][bj][m][0], v1 = acc[ai][bj][m][1];
                    u32x4 o; o.x = cvt_pk_bf16(v0[0], v0[1]); o.y = cvt_pk_bf16(v0[2], v0[3]); o.z = cvt_pk_bf16(v1[0], v1[1]); o.w = cvt_pk_bf16(v1[2], v1[3]);
                    *(u32x4*)(rowp + bj * HALF) = o; } }
    }
};
}

#define XB_TMO      128
#define XB_XCNT(j)  (256  + 64 * (j))
#define XB_XSUB(j)  (1280 + 64 * (j))
#define XB_XGEN(j)  (2304 + 64 * (j))
#define XB_TOP      3328
#define XB_TOPGEN   3392
#define XCD_BAR_WORDS 3456
#define XB_SPIN_CAP (1u << 18)
__device__ __forceinline__ unsigned xb_ld(unsigned* p)              { return __hip_atomic_load(p, __ATOMIC_RELAXED, __HIP_MEMORY_SCOPE_AGENT); }
__device__ __forceinline__ unsigned xb_add(unsigned* p, unsigned v) { return __hip_atomic_fetch_add(p, v, __ATOMIC_RELAXED, __HIP_MEMORY_SCOPE_AGENT); }
__device__ __forceinline__ unsigned xb_xcc_id() { return (unsigned)__builtin_amdgcn_s_getreg((3 << 11) | 20) & 0xFu; }
#define XB_SPIN(cond, bar) do { unsigned _sp = 0; while (cond) { __builtin_amdgcn_s_sleep(1); \
    if ((++_sp & 255u) == 0u) { if (xb_ld(&(bar)[XB_TMO])) break; if (_sp > XB_SPIN_CAP) { atomicAdd(&(bar)[XB_TMO], 1u); break; } } } } while (0)
struct XcdBarrier { unsigned* bar; unsigned x; volatile LAS unsigned* st; };
__device__ __forceinline__ XcdBarrier xcd_barrier_post(unsigned* bar, volatile LAS unsigned* st) {
    XcdBarrier b; b.bar = bar; b.x = xb_xcc_id(); b.st = st;
    if (threadIdx.x == 0) (void)xb_add(&bar[XB_XCNT(b.x)], 1u);
    return b;
}
__device__ __forceinline__ void xcd_barrier_complete(unsigned* bar, unsigned x, unsigned& nloc, unsigned& nx) {
    const unsigned G = gridDim.x * gridDim.y * gridDim.z;
    unsigned sum, cnt, mine, sp = 0u;
    for (;;) {
        sum = 0u; cnt = 0u; mine = 0u;
#pragma unroll
        for (unsigned j = 0; j < 16; ++j) { const unsigned c = xb_ld(&bar[XB_XCNT(j)]); sum += c; cnt += (c > 0u) ? 1u : 0u; mine = (j == x) ? c : mine; }
        if (sum == G) break;
        __builtin_amdgcn_s_sleep(1);
        if ((++sp & 255u) == 0u) { if (xb_ld(&bar[XB_TMO])) break; if (sp > XB_SPIN_CAP) { atomicAdd(&bar[XB_TMO], 1u); break; } }
    }
    nloc = mine > 0u ? mine : 1u; nx = cnt > 0u ? cnt : 1u;
}
__device__ __forceinline__ void xcd_barrier(const XcdBarrier& b) {
    asm volatile("s_waitcnt vmcnt(0)" ::: "memory");
    __syncthreads();
    if (threadIdx.x == 0) {
        unsigned* bar = b.bar;
        __builtin_amdgcn_s_waitcnt(0);
        unsigned nloc = b.st[0], nx = b.st[1];
        if (nloc == 0u) { xcd_barrier_complete(bar, b.x, nloc, nx); b.st[0] = nloc; b.st[1] = nx; }
        const unsigned old = xb_add(&bar[XB_XSUB(b.x)], 1u);
        const unsigned gen = old / nloc;
        if (old + 1u == (gen + 1u) * nloc) {
            __builtin_amdgcn_fence(__ATOMIC_RELEASE, "agent");
            asm volatile("s_waitcnt vmcnt(0)" ::: "memory");
            const unsigned og = xb_add(&bar[XB_TOP], 1u);
            const unsigned tg = og / nx;
            if (og + 1u == (tg + 1u) * nx) xb_add(&bar[XB_TOPGEN], 1u);
            else XB_SPIN(xb_ld(&bar[XB_TOPGEN]) == tg, bar);
            __builtin_amdgcn_fence(__ATOMIC_ACQUIRE, "agent");
            xb_add(&bar[XB_XGEN(b.x)], 1u);
            asm volatile("s_waitcnt vmcnt(0)" ::: "memory");
        } else {
            XB_SPIN(xb_ld(&bar[XB_XGEN(b.x)]) == gen, bar);
            __builtin_amdgcn_fence(__ATOMIC_ACQUIRE, "agent");
            asm volatile("s_waitcnt vmcnt(0)" ::: "memory");
        }
    }
    __syncthreads();
}
constexpr int MISC_OFF = 139264;
constexpr size_t CTL_BYTES = 16384;

struct Args { const float* in[27]; float* out; unsigned char* ws; int ph_lo, ph_hi; };

struct TItem { const float* W; bf16_t* WT; int K, N, item; };
__device__ __forceinline__ void transpose_load(const TItem& t, int lane, f32x4 (&v)[8]) {
    const int nblk = t.N / 32, kb = t.item / nblk, nb = t.item % nblk, k0 = 64 * kb, n0 = 32 * nb;
    const int kr = lane >> 3, n4 = (lane & 7) * 4;
#pragma unroll
    for (int i = 0; i < 8; ++i) v[i] = *(const f32x4*)(t.W + (size_t)(k0 + i * 8 + kr) * t.N + n0 + n4);
}
__device__ __forceinline__ void transpose_store(const TItem& t, int lane, const f32x4 (&v)[8], LAS float* scr) {
    const int nblk = t.N / 32, kb = t.item / nblk, nb = t.item % nblk, k0 = 64 * kb, n0 = 32 * nb;
    const int kr = lane >> 3, n4 = (lane & 7) * 4;
#pragma unroll
    for (int i = 0; i < 8; ++i) { LAS float* d = scr + (i * 8 + kr) * 33 + n4; d[0] = v[i].x; d[1] = v[i].y; d[2] = v[i].z; d[3] = v[i].w; }
    LDS_WAIT();
    const int c = lane & 7;
#pragma unroll
    for (int j = 0; j < 4; ++j) { const int n = (lane >> 3) + 8 * j; const LAS float* s = scr + (8 * c) * 33 + n;
        u32x4 o; o.x = cvt_pk_bf16(s[0 * 33], s[1 * 33]); o.y = cvt_pk_bf16(s[2 * 33], s[3 * 33]); o.z = cvt_pk_bf16(s[4 * 33], s[5 * 33]); o.w = cvt_pk_bf16(s[6 * 33], s[7 * 33]);
        *(u32x4*)(t.WT + (size_t)(n0 + n) * t.K + k0 + 8 * c) = o; }
    LDS_WAIT();
}

__device__ __forceinline__ void p0_prep(const Args& a, LAS unsigned char* lds, int tid, int lane, int wave, int G) {
    unsigned char* ws = a.ws;
    {
        LAS float* s = (LAS float*)lds; LAS float* part = (LAS float*)(lds + 36864);
        const float* c = a.in[1]; const float* cc = a.in[3]; const float* wm = a.in[4]; const float* bm = a.in[5];
        float* mod = (float*)(ws + WS_MOD);
        bool have = false;
        for (int bi = blockIdx.x; bi < 192; bi += G) {
            if (!have) { for (int idx = tid; idx < 9 * 1024; idx += 512) { const int r = idx >> 10, k = idx & 1023; const float v = (r < 8) ? c[r * 1024 + k] : cc[k]; s[idx] = v * sigmoid_f(v); } have = true; }
            __syncthreads();
            const int q = tid & 7, ks = tid >> 3, j = bi * 32 + 4 * q;
            f32x4 w[16];
#pragma unroll
            for (int kk = 0; kk < 16; ++kk) w[kk] = *(const f32x4*)(wm + (size_t)(ks * 16 + kk) * 6144 + j);
            f32x4 acc[9];
#pragma unroll
            for (int r = 0; r < 9; ++r) acc[r] = (f32x4){0.f, 0.f, 0.f, 0.f};
#pragma unroll
            for (int kk = 0; kk < 16; ++kk) {
#pragma unroll
                for (int r = 0; r < 9; ++r) acc[r] += s[r * 1024 + ks * 16 + kk] * w[kk]; }
#pragma unroll
            for (int r = 0; r < 9; ++r) *(LAS f32x4*)(part + ((ks * 9 + r) * 32 + 4 * q)) = acc[r];
            __syncthreads();
            if (tid < 288) { const int r = tid >> 5, col = tid & 31; float sum = bm[bi * 32 + col];
                for (int k2 = 0; k2 < 64; ++k2) sum += part[(k2 * 9 + r) * 32 + col];
                mod[r * 6144 + bi * 32 + col] = sum; }
            __syncthreads();
        }
    }
    {
        const float* pw = a.in[11]; const float* psc = a.in[12]; const float* wpp = a.in[20];
        bf16_t* wt = (bf16_t*)(ws + WS_WPP);
        LAS float* PWt = (LAS float*)lds; LAS float* WPs = (LAS float*)(lds + 65536);
        for (int fi = blockIdx.x; fi < 256; fi += G) {
            const int g = fi >> 6, ib = (fi >> 4) & 3, nbk = fi & 15;
#pragma unroll
            for (int t = 0; t < 8; ++t) { const int idx = tid + 512 * t, i = idx & 63, j4 = idx >> 6;
                const f32x4 v = *(const f32x4*)(pw + (size_t)(g * 256 + ib * 64 + i) * 256 + 4 * j4);
                PWt[(4 * j4 + 0) * 64 + i] = v.x; PWt[(4 * j4 + 1) * 64 + i] = v.y; PWt[(4 * j4 + 2) * 64 + i] = v.z; PWt[(4 * j4 + 3) * 64 + i] = v.w; }
#pragma unroll
            for (int t = 0; t < 8; ++t) { const int idx = tid + 512 * t, j = idx >> 4, n4 = idx & 15;
                const f32x4 v = *(const f32x4*)(wpp + (size_t)(g * 256 + j) * 1024 + nbk * 64 + 4 * n4) * psc[g * 256 + j];
                *(LAS f32x4*)(WPs + j * 64 + 4 * n4) = v; }
            __syncthreads();
            const int tn = tid & 31, ti = tid >> 5;
            f32x4 acc0 = (f32x4){0.f, 0.f, 0.f, 0.f}, acc1 = (f32x4){0.f, 0.f, 0.f, 0.f};
#pragma unroll 8
            for (int j = 0; j < 256; ++j) { const f32x4 av = *(const LAS f32x4*)(PWt + j * 64 + 4 * ti); const f32x2 bv = *(const LAS f32x2*)(WPs + j * 64 + 2 * tn);
                acc0 += av * bv.x; acc1 += av * bv.y; }
            const int n = nbk * 64 + 2 * tn, k0 = g * 256 + ib * 64 + 4 * ti;
            u32x2 o0, o1; o0.x = cvt_pk_bf16(acc0.x, acc0.y); o0.y = cvt_pk_bf16(acc0.z, acc0.w); o1.x = cvt_pk_bf16(acc1.x, acc1.y); o1.y = cvt_pk_bf16(acc1.z, acc1.w);
            *(u32x2*)(wt + (size_t)n * 1024 + k0) = o0; *(u32x2*)(wt + (size_t)(n + 1) * 1024 + k0) = o1;
            __syncthreads();
        }
    }
    {
        LAS float* scr = (LAS float*)(lds + wave * 16384);
        const int gw = (G - 1 - (int)blockIdx.x) * 8 + wave, NGW = G * 8;
        constexpr int I_IN = 16 * 160, I_LP = 16 * 32, I_OUT = 16 * 32, I_UP = 16 * 192, I_DN = 48 * 32, I_C = 32 * 8;
        constexpr int NIT = I_IN + I_LP + I_OUT + I_UP + I_DN + I_C;
        auto decode = [&](int it) -> TItem {
            int r = it;
            if (r < I_IN) return TItem{a.in[10], (bf16_t*)(ws + WS_WIN), 1024, DIN, r}; r -= I_IN;
            if (r < I_LP) return TItem{a.in[21], (bf16_t*)(ws + WS_WLP), 1024, 1024, r}; r -= I_LP;
            if (r < I_OUT) return TItem{a.in[22], (bf16_t*)(ws + WS_WOUT), 1024, 1024, r}; r -= I_OUT;
            if (r < I_UP) return TItem{a.in[23], (bf16_t*)(ws + WS_WUP), 1024, 2 * DFF, r}; r -= I_UP;
            if (r < I_DN) return TItem{a.in[26], (bf16_t*)(ws + WS_WDOWN), DFF, 1024, r}; r -= I_DN;
            const int mat = r >> 3, sub = r & 7, dir = mat >> 4, ax = (mat >> 3) & 1, blk = mat & 7;
            return TItem{(ax ? a.in[17] : a.in[15]) + (size_t)(dir * 8 + blk) * 16384, (bf16_t*)(ws + WS_WC) + (size_t)mat * 16384, 128, 128, sub};
        };
        for (int it = gw; it < NIT; it += 2 * NGW) {
            const TItem ta = decode(it); f32x4 va[8]; transpose_load(ta, lane, va);
            const bool two = it + NGW < NIT;
            const TItem tb = decode(two ? it + NGW : it); f32x4 vb[8];
            if (two) transpose_load(tb, lane, vb);
            transpose_store(ta, lane, va, scr);
            if (two) transpose_store(tb, lane, vb, scr);
        }
    }
}

__device__ __forceinline__ void p1_norm1(const Args& a, int lane, int gw, int NGW) {
    const float* mod = (const float*)(a.ws + WS_MOD); const float* gpre = a.in[6]; bf16_t* hx = (bf16_t*)(a.ws + WS_HX);
    f32x4 g4[4];
#pragma unroll
    for (int j = 0; j < 4; ++j) g4[j] = *(const f32x4*)(gpre + 4 * (lane + 64 * j));
    constexpr int NR = 9, PF = 3;
    for (int c = gw; c < MT / NR; c += NGW) {
        const int m0 = c * NR;
        const int mrA = m0 < M ? (m0 >> 11) : 8, mrB = (m0 + NR - 1) < M ? ((m0 + NR - 1) >> 11) : 8;
        f32x4 sA[4], hA[4], sB[4], hB[4];
#pragma unroll
        for (int j = 0; j < 4; ++j) { const int col = 4 * (lane + 64 * j);
            hA[j] = *(const f32x4*)(mod + mrA * 6144 + col); sA[j] = *(const f32x4*)(mod + mrA * 6144 + 1024 + col);
            hB[j] = *(const f32x4*)(mod + mrB * 6144 + col); sB[j] = *(const f32x4*)(mod + mrB * 6144 + 1024 + col); }
        f32x4 v[NR][4];
#define P1_LOAD(r_) do { const int mm = m0 + (r_); const float* src = mm < M ? a.in[0] + (size_t)mm * D : a.in[2] + (size_t)(mm - M) * D; \
            _Pragma("unroll") for (int j = 0; j < 4; ++j) v[r_][j] = ((const f32x4*)src)[lane + 64 * j]; } while (0)
#pragma unroll
        for (int r = 0; r < PF; ++r) P1_LOAD(r);
#pragma unroll
        for (int r = 0; r < NR; ++r) {
            asm volatile("" ::: "memory");
            if (r + PF < NR) P1_LOAD(r + PF);
            asm volatile("" ::: "memory");
            const int m = m0 + r; const bool useA = (m < M ? (m >> 11) : 8) == mrA;
            float ss = 0.f;
#pragma unroll
            for (int j = 0; j < 4; ++j) ss += (v[r][j].x * v[r][j].x + v[r][j].y * v[r][j].y) + (v[r][j].z * v[r][j].z + v[r][j].w * v[r][j].w);
            const float rstd = rsqrtf(wave_sum(ss) * (1.f / D) + EPS);
#pragma unroll
            for (int j = 0; j < 4; ++j) { const int col = 4 * (lane + 64 * j);
                const f32x4 s4 = useA ? sA[j] : sB[j], h4 = useA ? hA[j] : hB[j];
                const f32x4 y = v[r][j] * rstd * g4[j] * (1.f + s4) + h4;
                u32x2 o; o.x = cvt_pk_bf16(y.x, y.y); o.y = cvt_pk_bf16(y.z, y.w);
                *(u32x2*)(hx + (size_t)m * D + col) = o; }
        }
#undef P1_LOAD
    }
}

constexpr int PROW = 4160;
template <int HW>
__device__ __forceinline__ void pool_body(LAS unsigned char* img, const bf16_t* up, bf16_t* dp, int b, int ch0, int tid) {
    {
        const int r = tid >> 4, cp = tid & 15;
        LAS unsigned char* rowb = img + r * PROW + cp * 4;
        unsigned v[64];
#pragma unroll
        for (int c = 0; c < 64; ++c) v[c] = *(LAS unsigned*)(rowb + c * 64);
        float slo = 0.f, shi = 0.f;
#pragma unroll
        for (int c = 0; c < HW; ++c) { slo += bf_lo(v[c]); shi += bf_hi(v[c]); }
#pragma unroll
        for (int c = 0; c < 64; ++c) {
            *(LAS unsigned*)(rowb + c * 64) = cvt_pk_bf16(slo, shi);
            if (c + HW < 64) { slo += bf_lo(v[c + HW]); shi += bf_hi(v[c + HW]); }
            if (c - HW >= 0) { slo -= bf_lo(v[c - HW]); shi -= bf_hi(v[c - HW]); }
        }
    }
    __syncthreads();
#pragma unroll
    for (int j = 0; j < 2; ++j) {
        const int p = tid + 512 * j, cp = p & 15, c = p >> 4;
        LAS unsigned char* colb = img + c * 64 + cp * 4;
        unsigned v[32];
#pragma unroll
        for (int r = 0; r < 32; ++r) v[r] = *(LAS unsigned*)(colb + r * PROW);
        const int clo = c - HW < 0 ? 0 : c - HW, chi = c + HW > 64 ? 64 : c + HW;
        const float ccnt = (float)(chi - clo);
        float slo = 0.f, shi = 0.f;
#pragma unroll
        for (int r = 0; r < HW; ++r) { slo += bf_lo(v[r]); shi += bf_hi(v[r]); }
#pragma unroll
        for (int r = 0; r < 32; ++r) {
            const int rlo = r - HW < 0 ? 0 : r - HW, rhi = r + HW > 32 ? 32 : r + HW;
            const float inv = 1.f / (ccnt * (float)(rhi - rlo));
            const size_t gi = (size_t)(b * SEQL + r * 64 + c) * D + ch0 + 2 * cp;
            const unsigned uu = *(const unsigned*)(up + gi);
            *(unsigned*)(dp + gi) = cvt_pk_bf16(slo * inv - bf_lo(uu), shi * inv - bf_hi(uu));
            if (r + HW < 32) { slo += bf_lo(v[r + HW]); shi += bf_hi(v[r + HW]); }
            if (r - HW >= 0) { slo -= bf_lo(v[r - HW]); shi -= bf_hi(v[r - HW]); }
        }
    }
}
__device__ __forceinline__ void p3_pool(const Args& a, LAS unsigned char* lds, int tid, int G) {
    const bf16_t* up = (const bf16_t*)(a.ws + WS_UPOOL); bf16_t* dp = (bf16_t*)(a.ws + WS_DP);
    for (int pi = blockIdx.x; pi < 256; pi += G) {
        const int b = pi >> 5, slab = pi & 31, ch0 = slab * 32, grp = slab >> 3;
#pragma unroll 4
        for (int i = 0; i < 16; ++i) { const int idx = tid + 512 * i, tok = idx >> 2, part = idx & 3;
            const u32x4 val = *(const u32x4*)(up + (size_t)(b * SEQL + tok) * D + ch0 + part * 8);
            *(LAS u32x4*)(lds + (tok >> 6) * PROW + (tok & 63) * 64 + part * 16) = val; }
        __syncthreads();
        if (grp == 0) pool_body<1>(lds, up, dp, b, ch0, tid);
        else if (grp == 1) pool_body<2>(lds, up, dp, b, ch0, tid);
        else if (grp == 2) pool_body<4>(lds, up, dp, b, ch0, tid);
        else pool_body<8>(lds, up, dp, b, ch0, tid);
        __syncthreads();
    }
}

constexpr int LA_STRIDE = 272;
constexpr int LA_BYTES = 128 * LA_STRIDE;
constexpr int LS_OFF = LA_BYTES;
constexpr int HS_STRIDE = 132;

template <bool FINAL>
__device__ __forceinline__ void lru_item(const Args& a, LAS unsigned char* lds, int b, int q, int nb, int tid, int lane, int wave) {
    unsigned char* ws = a.ws;
    const bf16_t* ulru = (const bf16_t*)(ws + WS_ULRU);
    const bool isctx = q < 2;
    const int t0 = isctx ? q * 128 : (q - 2) * 128;
    const int seglen = isctx ? CTXL : SEQL;
    const size_t rowbase = isctx ? (size_t)(M + b * CTXL) : (size_t)(b * SEQL);
    {
        const int cg8 = tid & 15, tr = tid >> 4, ch = nb * 128 + cg8 * 8;
        const float* cw = a.in[13]; const float* cb = a.in[14];
        float wv[4][8], bias[8];
#pragma unroll
        for (int k = 0; k < 4; ++k) { const f32x4 w0 = *(const f32x4*)(cw + k * 1024 + ch), w1 = *(const f32x4*)(cw + k * 1024 + ch + 4);
            wv[k][0] = w0.x; wv[k][1] = w0.y; wv[k][2] = w0.z; wv[k][3] = w0.w; wv[k][4] = w1.x; wv[k][5] = w1.y; wv[k][6] = w1.z; wv[k][7] = w1.w; }
        { const f32x4 b0 = *(const f32x4*)(cb + ch), b1 = *(const f32x4*)(cb + ch + 4);
          bias[0] = b0.x; bias[1] = b0.y; bias[2] = b0.z; bias[3] = b0.w; bias[4] = b1.x; bias[5] = b1.y; bias[6] = b1.z; bias[7] = b1.w; }
        float ur[7][8];
        if (!FINAL && isctx) {
            const bf16_t* cp = (const bf16_t*)(ws + WS_CTXP);
#pragma unroll
            for (int i = 0; i < 7; ++i) { const int tok = t0 + tr * 4 - 2 + i;
#pragma unroll
                for (int e = 0; e < 8; ++e) ur[i][e] = 0.f;
                if (tok >= 0 && tok < seglen) {
#pragma unroll
                    for (int p = 0; p < 4; ++p) { const u32x4 val = *(const u32x4*)(cp + ((size_t)p * MC + b * CTXL + tok) * D + ch);
                        ur[i][0] += bf_lo(val.x); ur[i][1] += bf_hi(val.x); ur[i][2] += bf_lo(val.y); ur[i][3] += bf_hi(val.y);
                        ur[i][4] += bf_lo(val.z); ur[i][5] += bf_hi(val.z); ur[i][6] += bf_lo(val.w); ur[i][7] += bf_hi(val.w); } } }
        } else {
#pragma unroll
        for (int i = 0; i < 7; ++i) { const int tok = t0 + tr * 4 - 2 + i;
            u32x4 val = (u32x4){0u, 0u, 0u, 0u};
            if (tok >= 0 && tok < seglen) val = *(const u32x4*)(ulru + (rowbase + tok) * D + ch);
            ur[i][0] = bf_lo(val.x); ur[i][1] = bf_hi(val.x); ur[i][2] = bf_lo(val.y); ur[i][3] = bf_hi(val.y);
            ur[i][4] = bf_lo(val.z); ur[i][5] = bf_hi(val.z); ur[i][6] = bf_lo(val.w); ur[i][7] = bf_hi(val.w); }
        }
#pragma unroll
        for (int tk = 0; tk < 4; ++tk) { float xc[8];
#pragma unroll
            for (int e = 0; e < 8; ++e) { float s = bias[e];
#pragma unroll
                for (int k = 0; k < 4; ++k) s += ur[tk + k][e] * wv[k][e];
                xc[e] = s; }
            u32x4 o; o.x = cvt_pk_bf16(xc[0], xc[1]); o.y = cvt_pk_bf16(xc[2], xc[3]); o.z = cvt_pk_bf16(xc[4], xc[5]); o.w = cvt_pk_bf16(xc[6], xc[7]);
            *(LAS u32x4*)(lds + (tr * 4 + tk) * LA_STRIDE + cg8 * 16) = o; }
    }
    __syncthreads();
    const int dir = wave >> 2, cq = wave & 3, r32 = lane & 31, h = lane >> 5;
    const int chl = cq * 32 + r32, ch = nb * 128 + chl;
    f32x16 accA[4], accX[4];
    {
        const bf16_t* wc = (const bf16_t*)(ws + WS_WC);
        const bf16_t* wa = wc + ((size_t)((dir * 2 + 0) * 8 + nb) * 128 + chl) * 128 + h * 8;
        const bf16_t* wx = wc + ((size_t)((dir * 2 + 1) * 8 + nb) * 128 + chl) * 128 + h * 8;
        bf16x8 Ba[8], Bx[8];
#pragma unroll
        for (int ks = 0; ks < 8; ++ks) { Ba[ks] = *(const bf16x8*)(wa + ks * 16); Bx[ks] = *(const bf16x8*)(wx + ks * 16); }
        const float lam = a.in[19][dir * 1024 + ch], ba = a.in[16][dir * 1024 + ch], bx = a.in[18][dir * 1024 + ch];
        const float sp = log1pf(__expf(-lam));
        const float k2 = -8.f * sp * 1.4426950409f;
#define LRU_MFMA_TILE(tt) do { _Pragma("unroll") for (int i = 0; i < 16; ++i) { accA[tt][i] = 0.f; accX[tt][i] = 0.f; } \
        _Pragma("unroll") for (int ks = 0; ks < 8; ++ks) { \
            const bf16x8 Af = *(const LAS bf16x8*)(lds + ((tt) * 32 + r32) * LA_STRIDE + (ks * 16 + h * 8) * 2); \
            accA[tt] = __builtin_amdgcn_mfma_f32_32x32x16_bf16(Af, Ba[ks], accA[tt], 0, 0, 0); \
            accX[tt] = __builtin_amdgcn_mfma_f32_32x32x16_bf16(Af, Bx[ks], accX[tt], 0, 0, 0); } } while (0)
        LAS f32x2* Sg = (LAS f32x2*)(lds + LS_OFF) + (wave * 32 + r32) * 33;
#define LRU_COEF_TILE(tt) do { _Pragma("unroll") for (int i = 0; i < 16; ++i) { \
            const int tokl = (tt) * 32 + (i & 3) + 8 * (i >> 2) + 4 * h; \
            const float xcv = bf2f(*(const LAS bf16_t*)(lds + tokl * LA_STRIDE + chl * 2)); \
            const float r = sigmoid_f(accA[tt][i] + ba), ii = sigmoid_f(accX[tt][i] + bx); \
            const float av = __builtin_amdgcn_exp2f(k2 * r); \
            const float mult = __builtin_amdgcn_sqrtf(fmaxf(1.f - av * av, 0.f)); \
            accA[tt][i] = av; accX[tt][i] = mult * ii * xcv; } } while (0)
#define LRU_SUM_TILE(tt) do { _Pragma("unroll") for (int j = 0; j < 4; ++j) { \
            const float a0 = accA[tt][4 * j], a1 = accA[tt][4 * j + 1], a2 = accA[tt][4 * j + 2], a3 = accA[tt][4 * j + 3]; \
            const float b0 = accX[tt][4 * j], b1 = accX[tt][4 * j + 1], b2 = accX[tt][4 * j + 2], b3 = accX[tt][4 * j + 3]; \
            f32x2 s; s.x = (a0 * a1) * (a2 * a3); \
            s.y = dir == 0 ? ((b0 * a1 + b1) * a2 + b2) * a3 + b3 : ((b3 * a2 + b2) * a1 + b1) * a0 + b0; \
            Sg[(tt) * 8 + j * 2 + h] = s; } } while (0)
        if constexpr (!FINAL) {
            LRU_MFMA_TILE(0);
            __builtin_amdgcn_sched_barrier(0); LRU_MFMA_TILE(1); __builtin_amdgcn_sched_barrier(0); LRU_COEF_TILE(0); LRU_SUM_TILE(0);
            __builtin_amdgcn_sched_barrier(0); LRU_MFMA_TILE(2); __builtin_amdgcn_sched_barrier(0); LRU_COEF_TILE(1); LRU_SUM_TILE(1);
            __builtin_amdgcn_sched_barrier(0); LRU_MFMA_TILE(3); __builtin_amdgcn_sched_barrier(0); LRU_COEF_TILE(2); LRU_SUM_TILE(2);
            __builtin_amdgcn_sched_barrier(0); LRU_COEF_TILE(3); LRU_SUM_TILE(3);
        } else {
            LRU_MFMA_TILE(0);
            __builtin_amdgcn_sched_barrier(0); LRU_MFMA_TILE(1); __builtin_amdgcn_sched_barrier(0); LRU_COEF_TILE(0); LRU_SUM_TILE(0);
            __builtin_amdgcn_sched_barrier(0); LRU_MFMA_TILE(2); __builtin_amdgcn_sched_barrier(0); LRU_COEF_TILE(1); LRU_SUM_TILE(1);
            __builtin_amdgcn_sched_barrier(0); LRU_MFMA_TILE(3); __builtin_amdgcn_sched_barrier(0); LRU_COEF_TILE(2); LRU_SUM_TILE(2);
            __builtin_amdgcn_sched_barrier(0); LRU_COEF_TILE(3); LRU_SUM_TILE(3);
        }
#undef LRU_MFMA_TILE
#undef LRU_COEF_TILE
#undef LRU_SUM_TILE
    }
    LAS f32x2* Sg = (LAS f32x2*)(lds + LS_OFF) + (wave * 32 + r32) * 33;
    LDS_WAIT();
    f32x2* sum = (f32x2*)(ws + WS_SUM);
    if (h == 0) {
        float hc = 0.f;
        if (FINAL) {
            const int cnt = dir == 0 ? q : 2 + (NCHUNK - 1 - q);
#pragma unroll
            for (int k0 = 0; k0 < 20; k0 += 10) {
                f32x2 cs[10];
#pragma unroll
                for (int kk = 0; kk < 10; ++kk) { const int k = k0 + kk; const int c = dir == 0 ? k : (k == 0 ? 1 : (k == 1 ? 0 : NCHUNK + 1 - k));
                    cs[kk] = (f32x2){1.f, 0.f}; if (k < cnt) cs[kk] = sum[(size_t)((b * NCHUNK + c) * 2 + dir) * 1024 + ch]; }
#pragma unroll
                for (int kk = 0; kk < 10; ++kk) hc = cs[kk].x * hc + cs[kk].y;
            }
        }
        float pt = 1.f;
        if (dir == 0) {
#pragma unroll 8
            for (int g = 0; g < 32; ++g) { const f32x2 s = Sg[g]; if (FINAL) Sg[g].x = hc; hc = s.x * hc + s.y; pt *= s.x; }
        } else {
#pragma unroll 8
            for (int g = 31; g >= 0; --g) { const f32x2 s = Sg[g]; if (FINAL) Sg[g].x = hc; hc = s.x * hc + s.y; pt *= s.x; }
        }
        if (!FINAL) { f32x2 s; s.x = pt; s.y = hc; sum[(size_t)((b * NCHUNK + q) * 2 + dir) * 1024 + ch] = s; }
    }
    if (FINAL) {
        LDS_WAIT();
#pragma unroll
        for (int tt = 0; tt < 4; ++tt)
#pragma unroll
            for (int j = 0; j < 4; ++j) {
                float hh = Sg[tt * 8 + j * 2 + h].x;
                if (dir == 0) {
#pragma unroll
                    for (int k = 0; k < 4; ++k) { hh = accA[tt][4 * j + k] * hh + accX[tt][4 * j + k]; accX[tt][4 * j + k] = hh; }
                } else {
#pragma unroll
                    for (int k = 3; k >= 0; --k) { hh = accA[tt][4 * j + k] * hh + accX[tt][4 * j + k]; accX[tt][4 * j + k] = hh; }
                }
            }
        u32x4 gvp[4];
        { const int cg8 = tid & 15, tr = tid >> 4; const bf16_t* gg = (const bf16_t*)(ws + WS_GG);
#pragma unroll
          for (int tk = 0; tk < 4; ++tk) gvp[tk] = *(const u32x4*)(gg + (size_t)(b * SEQL + t0 + tr * 4 + tk) * D + nb * 128 + cg8 * 8); }
        __syncthreads();
        LAS float* hs = (LAS float*)(lds + LS_OFF);
        if (dir == 0) {
#pragma unroll
            for (int tt = 0; tt < 4; ++tt)
#pragma unroll
                for (int i = 0; i < 16; ++i) hs[(tt * 32 + (i & 3) + 8 * (i >> 2) + 4 * h) * HS_STRIDE + chl] = accX[tt][i];
        }
        __syncthreads();
        if (dir == 1) {
#pragma unroll
            for (int tt = 0; tt < 4; ++tt)
#pragma unroll
                for (int i = 0; i < 16; ++i) hs[(tt * 32 + (i & 3) + 8 * (i >> 2) + 4 * h) * HS_STRIDE + chl] += accX[tt][i];
        }
        __syncthreads();
        {
            const int cg8 = tid & 15, tr = tid >> 4;
            const bf16_t* gg = (const bf16_t*)(ws + WS_GG); bf16_t* yl = (bf16_t*)(ws + WS_YLRU);
#pragma unroll
            for (int tk = 0; tk < 4; ++tk) { const int tokl = tr * 4 + tk;
                const f32x4 h0 = *(const LAS f32x4*)(hs + tokl * HS_STRIDE + cg8 * 8), h1 = *(const LAS f32x4*)(hs + tokl * HS_STRIDE + cg8 * 8 + 4);
                const size_t gi = (size_t)(b * SEQL + t0 + tokl) * D + nb * 128 + cg8 * 8;
                const u32x4 gv = gvp[tk];
                u32x4 o; o.x = cvt_pk_bf16(h0.x * bf_lo(gv.x), h0.y * bf_hi(gv.x)); o.y = cvt_pk_bf16(h0.z * bf_lo(gv.y), h0.w * bf_hi(gv.y));
                o.z = cvt_pk_bf16(h1.x * bf_lo(gv.z), h1.y * bf_hi(gv.z)); o.w = cvt_pk_bf16(h1.z * bf_lo(gv.w), h1.w * bf_hi(gv.w));
                *(u32x4*)(yl + gi) = o; }
        }
    }
    __syncthreads();
}

__device__ __forceinline__ void p8_norm2(const Args& a, int lane, int gw, int NGW) {
    const float* mod = (const float*)(a.ws + WS_MOD); const bf16_t* mix = (const bf16_t*)(a.ws + WS_MIX);
    const float* gpm = a.in[7]; const float* gpf = a.in[8]; bf16_t* h2 = (bf16_t*)(a.ws + WS_H2);
    for (int grp = gw; grp < M / 8; grp += NGW) {
        const int m0 = grp * 8; const float* mb = mod + (m0 >> 11) * 6144;
        f32x4 g1[4], ga[4], g2[4], sc[4], sh[4];
#pragma unroll
        for (int j = 0; j < 4; ++j) { const int col = 4 * (lane + 64 * j); g1[j] = *(const f32x4*)(gpm + col); ga[j] = *(const f32x4*)(mb + 2048 + col);
            g2[j] = *(const f32x4*)(gpf + col); sc[j] = *(const f32x4*)(mb + 4096 + col); sh[j] = *(const f32x4*)(mb + 3072 + col); }
        f32x4 v[4], xv[4];
#pragma unroll
        for (int j = 0; j < 4; ++j) { { const u32x2 t_ = *(const u32x2*)(mix + (size_t)(m0) * D + 4 * (lane + 64 * j)); v[j] = (f32x4){bf_lo(t_.x), bf_hi(t_.x), bf_lo(t_.y), bf_hi(t_.y)}; } xv[j] = ((const f32x4*)(a.in[0] + (size_t)m0 * D))[lane + 64 * j]; }
        for (int k = 0; k < 8; ++k) {
            const int m = m0 + k;
            f32x4 vn[4], xn[4];
            if (k < 7) {
#pragma unroll
                for (int j = 0; j < 4; ++j) { { const u32x2 t_ = *(const u32x2*)(mix + (size_t)(m + 1) * D + 4 * (lane + 64 * j)); vn[j] = (f32x4){bf_lo(t_.x), bf_hi(t_.x), bf_lo(t_.y), bf_hi(t_.y)}; } xn[j] = ((const f32x4*)(a.in[0] + (size_t)(m + 1) * D))[lane + 64 * j]; }
            }
            float ss = 0.f;
#pragma unroll
            for (int j = 0; j < 4; ++j) ss += (v[j].x * v[j].x + v[j].y * v[j].y) + (v[j].z * v[j].z + v[j].w * v[j].w);
            const float rstd = rsqrtf(wave_sum(ss) * (1.f / D) + EPS);
            float s2 = 0.f;
#pragma unroll
            for (int j = 0; j < 4; ++j) { const int col = 4 * (lane + 64 * j);
                xv[j] = xv[j] + ga[j] * (v[j] * rstd * g1[j]);
                *(f32x4*)(a.out + (size_t)m * D + col) = xv[j];
                s2 += (xv[j].x * xv[j].x + xv[j].y * xv[j].y) + (xv[j].z * xv[j].z + xv[j].w * xv[j].w); }
            const float rstd2 = rsqrtf(wave_sum(s2) * (1.f / D) + EPS);
#pragma unroll
            for (int j = 0; j < 4; ++j) { const int col = 4 * (lane + 64 * j);
                const f32x4 y = xv[j] * rstd2 * g2[j] * (1.f + sc[j]) + sh[j];
                u32x2 o; o.x = cvt_pk_bf16(y.x, y.y); o.y = cvt_pk_bf16(y.z, y.w);
                *(u32x2*)(h2 + (size_t)m * D + col) = o; }
#pragma unroll
            for (int j = 0; j < 4; ++j) { v[j] = vn[j]; xv[j] = xn[j]; }
        }
    }
}
__device__ __forceinline__ void p12_final(const Args& a, int lane, int gw, int NGW) {
    const float* mod = (const float*)(a.ws + WS_MOD); const bf16_t* fx = (const bf16_t*)(a.ws + WS_FX); const float* gpo = a.in[9];
    for (int grp = gw; grp < M / 8; grp += NGW) {
        const int m0 = grp * 8; const float* mb = mod + (m0 >> 11) * 6144;
        f32x4 g4[4], ga[4];
#pragma unroll
        for (int j = 0; j < 4; ++j) { const int col = 4 * (lane + 64 * j); g4[j] = *(const f32x4*)(gpo + col); ga[j] = *(const f32x4*)(mb + 5120 + col); }
        f32x4 v[4], xv[4];
#pragma unroll
        for (int j = 0; j < 4; ++j) { { const u32x2 t_ = *(const u32x2*)(fx + (size_t)(m0) * D + 4 * (lane + 64 * j)); v[j] = (f32x4){bf_lo(t_.x), bf_hi(t_.x), bf_lo(t_.y), bf_hi(t_.y)}; } xv[j] = ((const f32x4*)(a.out + (size_t)m0 * D))[lane + 64 * j]; }
        for (int k = 0; k < 8; ++k) {
            const int m = m0 + k;
            f32x4 vn[4], xn[4];
            if (k < 7) {
#pragma unroll
                for (int j = 0; j < 4; ++j) { { const u32x2 t_ = *(const u32x2*)(fx + (size_t)(m + 1) * D + 4 * (lane + 64 * j)); vn[j] = (f32x4){bf_lo(t_.x), bf_hi(t_.x), bf_lo(t_.y), bf_hi(t_.y)}; } xn[j] = ((const f32x4*)(a.out + (size_t)(m + 1) * D))[lane + 64 * j]; }
            }
            float ss = 0.f;
#pragma unroll
            for (int j = 0; j < 4; ++j) ss += (v[j].x * v[j].x + v[j].y * v[j].y) + (v[j].z * v[j].z + v[j].w * v[j].w);
            const float rstd = rsqrtf(wave_sum(ss) * (1.f / D) + EPS);
#pragma unroll
            for (int j = 0; j < 4; ++j) *(f32x4*)(a.out + (size_t)m * D + 4 * (lane + 64 * j)) = xv[j] + ga[j] * (v[j] * rstd * g4[j]);
#pragma unroll
            for (int j = 0; j < 4; ++j) { v[j] = vn[j]; xv[j] = xn[j]; }
        }
    }
}

__device__ __forceinline__ void p10_conv(const Args& a, int lane, int gw, int NGW) {
    const bf16_t* gb = (const bf16_t*)(a.ws + WS_G); bf16_t* ub = (bf16_t*)(a.ws + WS_U);
    const float* cw = a.in[24]; const float* cb = a.in[25];
    for (int it = gw; it < NB * 16 * 8 * 12; it += NGW) {
        const int cbk = it % 12; int r = it / 12; const int co = r & 7; r >>= 3; const int rp = r & 15; const int b = r >> 4;
        const int ch = cbk * 256 + lane * 4, r0 = rp * 2, c0 = co * 8;
        u32x2 gin[4][10], uin[2][8];
#pragma unroll
        for (int ir = 0; ir < 4; ++ir)
#pragma unroll
            for (int ci = 0; ci < 10; ++ci) { const int rr = r0 - 1 + ir, cc = c0 - 1 + ci;
                gin[ir][ci] = (u32x2){0u, 0u};
                if (rr >= 0 && rr < 32 && cc >= 0 && cc < 64) gin[ir][ci] = *(const u32x2*)(gb + (size_t)(b * SEQL + rr * 64 + cc) * DFF + ch); }
#pragma unroll
        for (int o = 0; o < 2; ++o)
#pragma unroll
            for (int oc = 0; oc < 8; ++oc) uin[o][oc] = *(const u32x2*)(ub + (size_t)(b * SEQL + (r0 + o) * 64 + c0 + oc) * DFF + ch);
        f32x4 w[9];
#pragma unroll
        for (int k = 0; k < 9; ++k) w[k] = *(const f32x4*)(cw + k * DFF + ch);
        const f32x4 bias = *(const f32x4*)(cb + ch);
#pragma unroll
        for (int oc = 0; oc < 8; ++oc)
#pragma unroll
            for (int o = 0; o < 2; ++o) {
                f32x4 acc = bias;
#pragma unroll
                for (int ky = 0; ky < 3; ++ky)
#pragma unroll
                    for (int kx = 0; kx < 3; ++kx) { const u32x2 gv = gin[o + ky][oc + kx];
                        acc += (f32x4){bf_lo(gv.x), bf_hi(gv.x), bf_lo(gv.y), bf_hi(gv.y)} * w[ky * 3 + kx]; }
                const u32x2 uv = uin[o][oc];
                u32x2 ov; ov.x = cvt_pk_bf16(gelu_f(acc.x) * bf_lo(uv.x), gelu_f(acc.y) * bf_hi(uv.x)); ov.y = cvt_pk_bf16(gelu_f(acc.z) * bf_lo(uv.y), gelu_f(acc.w) * bf_hi(uv.y));
                *(u32x2*)(ub + (size_t)(b * SEQL + (r0 + o) * 64 + c0 + oc) * DFF + ch) = ov;
            }
    }
}

__global__ void __launch_bounds__(512, 2) mk_fwd(Args a) {
    extern __shared__ __attribute__((aligned(16))) unsigned char lds_raw[];
    LAS unsigned char* lds = (LAS unsigned char*)lds_raw;
    const int tid = threadIdx.x, lane = tid & 63, wave = __builtin_amdgcn_readfirstlane(tid >> 6);
    const int G = gridDim.x, gw = blockIdx.x * 8 + wave, NGW = G * 8;
    unsigned char* ws = a.ws;
    const int lo = a.ph_lo, hi = a.ph_hi;
#define IN(k) (lo <= (k) && (k) < hi)
#if MK_ONE
    cg::grid_group grid = cg::this_grid();
    if (hi > NPHASE) grid.sync();
    volatile LAS unsigned* misc = (volatile LAS unsigned*)(lds + MISC_OFF);
    if (tid < 16) misc[tid] = 0u;
    __syncthreads();
    const XcdBarrier bar = xcd_barrier_post((unsigned*)ws, misc);
#define SEAM(k) do { if (IN(k) && IN((k) + 1)) xcd_barrier(bar); } while (0)
#define REPBAR(r) do { if (r) xcd_barrier(bar); } while (0)
#else
#define SEAM(k) do { } while (0)
#define REPBAR(r) do { } while (0)
#endif
    using namespace pg8;

    for (int rep = 0; IN(0) && rep < 1 + ((MK_REP >> 0) & 1); ++rep) { REPBAR(rep); p0_prep(a, lds, tid, lane, wave, G); }
    SEAM(0);
    for (int rep = 0; IN(1) && rep < 1 + ((MK_REP >> 1) & 1); ++rep) { REPBAR(rep); p1_norm1(a, lane, gw, NGW); }
    SEAM(1);
    for (int rep = 0; IN(2) && rep < 1 + ((MK_REP >> 2) & 1); ++rep) { REPBAR(rep);
        Gemm g{(const bf16_t*)(ws + WS_HX), (const bf16_t*)(ws + WS_WIN), MT, DIN, D}; Order1 S{G, (int)blockIdx.x};
        Epi1 E{(bf16_t*)(ws + WS_UPOOL), (bf16_t*)(ws + WS_ULRU), (bf16_t*)(ws + WS_GG), (bf16_t*)(ws + WS_SGP), (bf16_t*)(ws + WS_SGL), (bf16_t*)(ws + WS_CTXP)};
        gemm_phase<Epi1, Order1, true, true>(lds, g, S, E);
    }
    SEAM(2);
    for (int rep = 0; IN(3) && rep < 1 + ((MK_REP >> 3) & 1); ++rep) { REPBAR(rep);
        p3_pool(a, lds, tid, G);
        for (int it = blockIdx.x; it < NB * NCHUNK * 8; it += G) { const int nb = it & 7, r = it >> 3; lru_item<false>(a, lds, r / NCHUNK, r % NCHUNK, nb, tid, lane, wave); }
    }
    SEAM(3);
    for (int rep = 0; IN(4) && rep < 1 + ((MK_REP >> 4) & 1); ++rep) { REPBAR(rep);
        for (int it = blockIdx.x; it < NB * 16 * 8; it += G) { const int nb = it & 7, r = it >> 3; lru_item<true>(a, lds, r >> 4, 2 + (r & 15), nb, tid, lane, wave); }
    }
    SEAM(4);
    for (int rep = 0; IN(5) && rep < 1 + ((MK_REP >> 5) & 1); ++rep) { REPBAR(rep);
        { Gemm g{(const bf16_t*)(ws + WS_DP), (const bf16_t*)(ws + WS_WPP), M, D, D}; StaticOrder S; S.init(M, D, G, (int)blockIdx.x, D);
          Epi2<false> E{(const bf16_t*)(ws + WS_SGP), (bf16_t*)(ws + WS_T1M)};
          gemm_phase<Epi2<false>, StaticOrder, false, true>(lds, g, S, E); }
        { Gemm g{(const bf16_t*)(ws + WS_YLRU), (const bf16_t*)(ws + WS_WLP), M, D, D}; StaticOrder S; S.init(M, D, G, (int)blockIdx.x, D);
          Epi2<true> E{(const bf16_t*)(ws + WS_SGL), (bf16_t*)(ws + WS_T1M)};
          gemm_phase<Epi2<true>, StaticOrder, false, true>(lds, g, S, E); }
    }
    SEAM(5);
    for (int rep = 0; IN(6) && rep < 1 + ((MK_REP >> 6) & 1); ++rep) { REPBAR(rep);
        Gemm g{(const bf16_t*)(ws + WS_T1M), (const bf16_t*)(ws + WS_WOUT), M, D, D}; StaticOrder S; S.init(M, D, G, (int)blockIdx.x, D);
        EpiBf16 E{(bf16_t*)(ws + WS_MIX), D};
        gemm_phase<EpiBf16, StaticOrder, false, true>(lds, g, S, E);
    }
    SEAM(6);
    for (int rep = 0; IN(7) && rep < 1 + ((MK_REP >> 7) & 1); ++rep) { REPBAR(rep); p8_norm2(a, lane, gw, NGW); }
    SEAM(7);
    for (int rep = 0; IN(8) && rep < 1 + ((MK_REP >> 8) & 1); ++rep) { REPBAR(rep);
        Gemm g{(const bf16_t*)(ws + WS_H2), (const bf16_t*)(ws + WS_WUP), M, 2 * DFF, D}; StaticOrder S; S.init(M, 2 * DFF, G, (int)blockIdx.x, D);
        Epi4 E{(bf16_t*)(ws + WS_G), (bf16_t*)(ws + WS_U)};
        gemm_phase<Epi4, StaticOrder, true, true>(lds, g, S, E);
    }
    SEAM(8);
    for (int rep = 0; IN(9) && rep < 1 + ((MK_REP >> 9) & 1); ++rep) { REPBAR(rep); p10_conv(a, lane, gw, NGW); }
    SEAM(9);
    for (int rep = 0; IN(10) && rep < 1 + ((MK_REP >> 10) & 1); ++rep) { REPBAR(rep);
        Gemm g{(const bf16_t*)(ws + WS_U), (const bf16_t*)(ws + WS_WDOWN), M, D, DFF}; StaticOrder S; S.init(M, D, G, (int)blockIdx.x, DFF);
        EpiBf16 E{(bf16_t*)(ws + WS_FX), D};
        gemm_phase<EpiBf16, StaticOrder, false, true>(lds, g, S, E);
    }
    SEAM(10);
    for (int rep = 0; IN(11) && rep < 1 + ((MK_REP >> 11) & 1); ++rep) { REPBAR(rep); p12_final(a, lane, gw, NGW); }
#undef IN
#undef SEAM
#undef REPBAR
}

extern "C" void kernel_launch(void* const* d_in, const int* in_sizes, int n_in, void* d_out, int out_size, void* d_ws, size_t ws_size, hipStream_t stream) {
    static int grid = 0;
    if (grid == 0) {
        if (n_in != 27 || in_sizes[0] != M * D || out_size != M * D || ws_size < WS_END) { fprintf(stderr, "kernel_launch: unexpected shapes (n_in %d, in0 %d, out %d, ws %zu)\n", n_in, n_in > 0 ? in_sizes[0] : -1, out_size, ws_size); grid = -1; return; }
        int dev = 0, cus = 0, per_cu = 0;
        if (hipGetDevice(&dev) != hipSuccess || hipDeviceGetAttribute(&cus, hipDeviceAttributeMultiprocessorCount, dev) != hipSuccess) { grid = -1; return; }
        if (hipFuncSetAttribute((const void*)mk_fwd, hipFuncAttributeMaxDynamicSharedMemorySize, LDS_BYTES) != hipSuccess) { fprintf(stderr, "kernel_launch: hipFuncSetAttribute failed\n"); grid = -1; return; }
        if (hipOccupancyMaxActiveBlocksPerMultiprocessor(&per_cu, (const void*)mk_fwd, 512, LDS_BYTES) != hipSuccess || per_cu < 1) { fprintf(stderr, "kernel_launch: occupancy query says %d\n", per_cu); per_cu = 1; }
        (void)hipGetLastError();
        grid = cus * 1;
    }
    if (grid < 0) return;
    Args a{};
    for (int i = 0; i < 27; ++i) a.in[i] = (const float*)d_in[i];
    a.out = (float*)d_out; a.ws = (unsigned char*)d_ws;
#if MK_ONE
    a.ph_lo = 0; a.ph_hi = NPHASE;
    if (hipMemsetAsync(d_ws, 0, CTL_BYTES, stream) != hipSuccess) { fprintf(stderr, "kernel_launch: memset of the barrier words failed\n"); return; }
    void* kargs[] = {&a};
    hipError_t e = hipLaunchCooperativeKernel((const void*)mk_fwd, dim3(grid), dim3(512), kargs, LDS_BYTES, stream);
    if (e != hipSuccess) fprintf(stderr, "cooperative launch failed: %s (grid %d)\n", hipGetErrorString(e), grid);
#else
    for (int p = 0; p < NPHASE; ++p) {
        a.ph_lo = p; a.ph_hi = p + 1;
        hipLaunchKernelGGL(mk_fwd, dim3(grid), dim3(512), LDS_BYTES, stream, a);
    }
#endif
}
```

```cpp
#include <hip/hip_runtime.h>
#include <hip/hip_cooperative_groups.h>
#include <cstdio>
#include <cstdint>
namespace cg = cooperative_groups;

#ifndef MK_ONE
#define MK_ONE 1
#endif

#ifndef MK_REP
#define MK_REP 0
#endif
#define LAS __attribute__((address_space(3)))
typedef unsigned short bf16_t;
typedef short bf16x8 __attribute__((ext_vector_type(8)));
typedef float f32x4 __attribute__((ext_vector_type(4)));
typedef float f32x2 __attribute__((ext_vector_type(2)));
typedef float f32x16 __attribute__((ext_vector_type(16)));
typedef unsigned u32x4 __attribute__((ext_vector_type(4)));
typedef unsigned u32x2 __attribute__((ext_vector_type(2)));

constexpr int D = 1024, NB = 8, SEQL = 2048, M = NB * SEQL, CTXL = 256, MC = NB * CTXL, MT = M + MC, DIN = 5120, DFF = 3072;
constexpr int NCHUNK = 18;
constexpr float EPS = 1e-6f;

constexpr size_t MiB = 1u << 20;
constexpr size_t WS_MOD = MiB / 2;
constexpr size_t WS_WC = 1 * MiB;
constexpr size_t WS_WUP = 2 * MiB;
constexpr size_t WS_WDOWN = 14 * MiB;
constexpr size_t WS_WIN = 20 * MiB;
constexpr size_t WS_WPP = 30 * MiB;
constexpr size_t WS_WLP = 32 * MiB;
constexpr size_t WS_WOUT = 34 * MiB;
constexpr size_t WS_SUM = 36 * MiB;
constexpr size_t WS_HX = 40 * MiB;
constexpr size_t WS_DP = 40 * MiB;
constexpr size_t WS_UPOOL = 76 * MiB;
constexpr size_t WS_YLRU = 76 * MiB;
constexpr size_t WS_ULRU = 108 * MiB;
constexpr size_t WS_GG = 144 * MiB;
constexpr size_t WS_T1M = 144 * MiB;
constexpr size_t WS_SGP = 176 * MiB;
constexpr size_t WS_SGL = 208 * MiB;
constexpr size_t WS_MIX = 176 * MiB;
constexpr size_t WS_H2 = 20 * MiB;
constexpr size_t WS_G = 52 * MiB;
constexpr size_t WS_U = 148 * MiB;
constexpr size_t WS_FX = 52 * MiB;
constexpr size_t WS_CTXP = 240 * MiB;
constexpr size_t WS_END = 256 * MiB;

constexpr int LDS_BYTES = 147456;
constexpr int NPHASE = 12;

__device__ __forceinline__ unsigned cvt_pk_bf16(float lo, float hi) { unsigned r; asm volatile("v_cvt_pk_bf16_f32 %0, %1, %2" : "=v"(r) : "v"(lo), "v"(hi)); return r; }
__device__ __forceinline__ float bf_lo(unsigned u) { return __builtin_bit_cast(float, u << 16); }
__device__ __forceinline__ float bf_hi(unsigned u) { return __builtin_bit_cast(float, u & 0xffff0000u); }
__device__ __forceinline__ float bf2f(bf16_t v) { return __builtin_bit_cast(float, ((unsigned)v) << 16); }
__device__ __forceinline__ float sigmoid_f(float x) { return __builtin_amdgcn_rcpf(1.f + __builtin_amdgcn_exp2f(-1.4426950409f * x)); }
__device__ __forceinline__ float gelu_f(float x) { const float y = x * (1.5957691216f + 0.0713548163f * x * x); return x * __builtin_amdgcn_rcpf(1.f + __builtin_amdgcn_exp2f(-1.4426950409f * y)); }
__device__ __forceinline__ float wave_sum(float v) {
#pragma unroll
    for (int o = 1; o < 64; o <<= 1) v += __shfl_xor(v, o);
    return v;
}
#define LDS_WAIT() asm volatile("s_waitcnt lgkmcnt(0)" ::: "memory")

namespace pg8 {
constexpr int BM = 256, BK = 64, HALF = 128, HTB = HALF * BK * 2, STAGE_BYTES = 8 * HTB, NXCD = 8, WGM = 8;
__host__ __device__ __forceinline__ int lds_byte(int r, int c) { const int st = (r >> 4) * 2 + (c >> 5), rr = r & 15, cc = c & 31, ob = rr * 64 + cc * 2; return st * 1024 + (ob ^ (((ob >> 9) & 1) << 5)); }
__host__ __device__ __forceinline__ void stage_rc(int b, int& R, int& C) { const int st = b / 1024, sb = b % 1024, swz = sb ^ (((sb >> 9) & 1) << 5); R = (st >> 1) * 16 + swz / 64; C = (st & 1) * 32 + (swz % 64) / 2; }
__host__ __device__ __forceinline__ int perm32(int rho) { const int n = rho >> 4, i = rho & 15; return 8 * (i >> 2) + 4 * n + (i & 3); }

struct Unit { int pm, pn, kt0, nt; };
struct Gemm { const bf16_t* A; const bf16_t* Bt; int M, N, K; };

__device__ __forceinline__ void tile_map(int wgid, int nM, int nN, Unit& u) {
    const int nwg = nM * nN;
    { const int q = nwg / NXCD, r = nwg % NXCD, xcd = wgid % NXCD, off = wgid / NXCD; wgid = (xcd < r ? xcd * (q + 1) : r * (q + 1) + (xcd - r) * q) + off; }
    const int nig = WGM * nN, gid = wgid / nig, fm = gid * WGM, gsz = (nM - fm) < WGM ? (nM - fm) : WGM;
    u.pm = fm + ((wgid % nig) % gsz); u.pn = (wgid % nig) / gsz;
}
struct StaticOrder {
    int nM, nN, nwg, G, c, ntk;
    __device__ void init(int M_, int N_, int G_, int c_, int K_) { nM = M_ / BM; nN = N_ / BM; nwg = nM * nN; G = G_; c = c_; ntk = K_ / BK; }
    __device__ bool next(int i, Unit& u) const {
        const long L = (long)i * G + c; if (L >= nwg) return false;
        tile_map((int)L, nM, nN, u); u.kt0 = 0; u.nt = ntk; return true;
    }
    __device__ __forceinline__ void a_ready(const Unit&) const {}
    __device__ __forceinline__ void done(const Unit&) const {}
};
struct Order1 {
    int G, c;
    __device__ bool next(int i, Unit& u) const {
        const long L = (long)i * G + c; if (L >= 1280 + 128) return false;
        if (L < 1280) { tile_map((int)L, 64, 20, u); u.kt0 = 0; u.nt = 16; }
        else { const int q = (int)L - 1280, cu = q >> 2; u.pm = 64 + (cu >> 2); u.pn = 4 + (cu & 3); u.kt0 = 4 * (q & 3); u.nt = 4; }
        return true;
    }
    __device__ __forceinline__ void a_ready(const Unit&) const {}
    __device__ __forceinline__ void done(const Unit&) const {}
};

typedef f32x4 Acc[2][2][4][2];

template <class Epi, class Sched, bool ALIGN_EPI = false, bool SP2 = false>
__device__ __forceinline__ void gemm_phase(LAS unsigned char* lds, const Gemm g, const Sched& S, const Epi& E) {
    const int tid = threadIdx.x, wid = __builtin_amdgcn_readfirstlane(tid >> 6), lane = tid & 63, wr = wid >> 2, wc = wid & 3, fr = lane & 15, fq = lane >> 4;
    const int K = g.K;
    unsigned voffA[2], voffB[2];
#pragma unroll
    for (int i = 0; i < 2; ++i) { int R, C; stage_rc(tid * 16 + i * 8192, R, C); const int Rb = Epi::PERM ? ((R & ~31) + perm32(R & 31)) : R;
        voffA[i] = (unsigned)(R * K + C) * 2u; voffB[i] = (unsigned)(Rb * K + C) * 2u; }
    const size_t kstep = (size_t)(BK * 2);
    const size_t hstep = (size_t)HALF * K * 2;
    const size_t tstep = 2 * hstep;
    const unsigned ldsw = (unsigned)wid * 1024u;
    const int aoff = lds_byte(wr * 64 + fr, fq * 8), boff = lds_byte(wc * 32 + fr, fq * 8);
#define PG8_SA(b, h) (((b) * 2 + (h)) * HTB)
#define PG8_SB(b, h) ((4 + (b) * 2 + (h)) * HTB)
#define PG8_STAGE(bufoff, gbase, voff) do { _Pragma("unroll") for (int _i = 0; _i < 2; ++_i) \
        __builtin_amdgcn_global_load_lds((const unsigned*)((const char*)(gbase) + (voff)[_i]), (LAS unsigned*)(lds + (bufoff) + ldsw + _i * 8192), 16, 0, 0); } while (0)
#define PG8_LDA(dst, b, h) do { _Pragma("unroll") for (int m = 0; m < 4; ++m) _Pragma("unroll") for (int k = 0; k < 2; ++k) dst[m][k] = *(const LAS bf16x8*)(lds + PG8_SA(b, h) + aoff + m * 2048 + k * 1024); } while (0)
#define PG8_LDB(dst, b, h) do { _Pragma("unroll") for (int n = 0; n < 2; ++n) _Pragma("unroll") for (int k = 0; k < 2; ++k) dst[n][k] = *(const LAS bf16x8*)(lds + PG8_SB(b, h) + boff + n * 2048 + k * 1024); } while (0)
#define PG8_MMA(ai, bj, At, Bt) do { __builtin_amdgcn_s_setprio(1); _Pragma("unroll") for (int m = 0; m < 4; ++m) _Pragma("unroll") for (int n = 0; n < 2; ++n) _Pragma("unroll") for (int k = 0; k < 2; ++k) \
        acc[ai][bj][m][n] = __builtin_amdgcn_mfma_f32_16x16x32_bf16(Bt[n][k], At[m][k], acc[ai][bj][m][n], 0, 0, 0); __builtin_amdgcn_s_setprio(0); } while (0)
#define PG8_WAIT_V(n) asm volatile("s_waitcnt vmcnt(" #n ")" ::: "memory")
#define PG8_WAIT_L(n) asm volatile("s_waitcnt lgkmcnt(" #n ")" ::: "memory")
#define PG8_BAR __builtin_amdgcn_s_barrier()
#define PG8_SCHED __builtin_amdgcn_sched_barrier(0)
    Unit cur, nxt; int ui = 0;
    if (!S.next(0, cur)) return;
    f32x4 acc[2][2][4][2];
#pragma unroll
    for (int a = 0; a < 2; ++a)
#pragma unroll
        for (int b = 0; b < 2; ++b)
#pragma unroll
            for (int m = 0; m < 4; ++m)
#pragma unroll
                for (int n = 0; n < 2; ++n) acc[a][b][m][n] = (f32x4){0.f, 0.f, 0.f, 0.f};
    bf16x8 At[4][2], B0[2][2], B1[2][2];
    const char* cA = (const char*)g.A + (size_t)cur.pm * tstep + (size_t)cur.kt0 * kstep; const char* cB = (const char*)g.Bt + (size_t)cur.pn * tstep + (size_t)cur.kt0 * kstep;
    S.a_ready(cur);
    if constexpr (SP2) {
        PG8_STAGE(PG8_SB(0, 0), cB, voffB); PG8_STAGE(PG8_SB(0, 1), cB + hstep, voffB); PG8_STAGE(PG8_SA(0, 0), cA, voffA); PG8_STAGE(PG8_SA(0, 1), cA + hstep, voffA);
        if (wr == 1) PG8_BAR;
        PG8_WAIT_V(2); PG8_BAR;
        PG8_STAGE(PG8_SB(1, 0), cB + kstep, voffB); PG8_STAGE(PG8_SA(1, 0), cA + kstep, voffA); PG8_STAGE(PG8_SB(1, 1), cB + hstep + kstep, voffB);
        PG8_WAIT_V(6); PG8_BAR;
    } else {
        PG8_STAGE(PG8_SB(0, 0), cB, voffB); PG8_STAGE(PG8_SA(0, 0), cA, voffA); PG8_STAGE(PG8_SB(0, 1), cB + hstep, voffB); PG8_STAGE(PG8_SA(0, 1), cA + hstep, voffA);
        if (wr == 1) PG8_BAR;
        PG8_WAIT_V(4); PG8_BAR;
        PG8_STAGE(PG8_SB(1, 0), cB + kstep, voffB); PG8_STAGE(PG8_SA(1, 0), cA + kstep, voffA); PG8_STAGE(PG8_SB(1, 1), cB + hstep + kstep, voffB);
        PG8_WAIT_V(6); PG8_BAR;
    }
    for (;;) {
        const bool has_next = S.next(ui + 1, nxt);
        const char* nA = has_next ? (const char*)g.A + (size_t)nxt.pm * tstep + (size_t)nxt.kt0 * kstep : cA; const char* nB = has_next ? (const char*)g.Bt + (size_t)nxt.pn * tstep + (size_t)nxt.kt0 * kstep : cB;
        const int nt = cur.nt;
        for (int t = 0; t < nt; t += 2) {
            const bool last = (t == nt - 2);
            const char* a1 = cA + (size_t)(t + 1) * kstep;
            const char* a2 = last ? nA : cA + (size_t)(t + 2) * kstep; const char* b2 = last ? nB : cB + (size_t)(t + 2) * kstep;
            const char* a3 = a2 + kstep; const char* b3 = b2 + kstep;
            if (last && has_next) S.a_ready(nxt);
            if constexpr (SP2) {
            PG8_LDB(B0, 0, 0); PG8_LDB(B1, 0, 1); PG8_SCHED; PG8_LDA(At, 0, 0); PG8_STAGE(PG8_SA(1, 1), a1 + hstep, voffA);
            PG8_WAIT_V(8); PG8_WAIT_L(0); PG8_BAR; PG8_MMA(0, 0, At, B0); PG8_MMA(0, 1, At, B1); PG8_BAR; PG8_SCHED;
            PG8_LDA(At, 0, 1); PG8_STAGE(PG8_SB(0, 0), b2, voffB); PG8_STAGE(PG8_SB(0, 1), b2 + hstep, voffB); PG8_STAGE(PG8_SA(0, 0), a2, voffA);
            PG8_WAIT_V(8); PG8_WAIT_L(0); PG8_BAR; PG8_MMA(1, 0, At, B0); PG8_MMA(1, 1, At, B1); PG8_BAR; PG8_SCHED;
            PG8_LDB(B0, 1, 0); PG8_LDB(B1, 1, 1); PG8_SCHED; PG8_LDA(At, 1, 0); PG8_STAGE(PG8_SA(0, 1), a2 + hstep, voffA);
            PG8_WAIT_V(8); PG8_WAIT_L(0); PG8_BAR; PG8_MMA(0, 0, At, B0); PG8_MMA(0, 1, At, B1); PG8_BAR; PG8_SCHED;
            PG8_LDA(At, 1, 1); PG8_STAGE(PG8_SB(1, 0), b3, voffB); PG8_STAGE(PG8_SB(1, 1), b3 + hstep, voffB); PG8_STAGE(PG8_SA(1, 0), a3, voffA);
            PG8_WAIT_V(8); PG8_WAIT_L(0); PG8_BAR; PG8_MMA(1, 0, At, B0); PG8_MMA(1, 1, At, B1); PG8_BAR; PG8_SCHED;
            } else {
            PG8_LDB(B0, 0, 0); PG8_SCHED; PG8_LDA(At, 0, 0); PG8_STAGE(PG8_SA(1, 1), a1 + hstep, voffA);
            PG8_WAIT_L(8); PG8_BAR; PG8_WAIT_L(0); PG8_MMA(0, 0, At, B0); PG8_BAR; PG8_SCHED;
            PG8_LDB(B1, 0, 1); PG8_STAGE(PG8_SB(0, 0), b2, voffB);
            PG8_BAR; PG8_WAIT_L(0); PG8_MMA(0, 1, At, B1); PG8_BAR;
            PG8_LDA(At, 0, 1); PG8_STAGE(PG8_SA(0, 0), a2, voffA);
            PG8_BAR; PG8_WAIT_L(0); PG8_MMA(1, 0, At, B0); PG8_BAR; PG8_SCHED;
            PG8_STAGE(PG8_SB(0, 1), b2 + hstep, voffB);
            PG8_WAIT_V(6); PG8_BAR; PG8_MMA(1, 1, At, B1); PG8_BAR;
            PG8_LDB(B0, 1, 0); PG8_SCHED; PG8_LDA(At, 1, 0); PG8_STAGE(PG8_SA(0, 1), a2 + hstep, voffA);
            PG8_WAIT_L(8); PG8_BAR; PG8_WAIT_L(0); PG8_MMA(0, 0, At, B0); PG8_BAR; PG8_SCHED;
            PG8_LDB(B1, 1, 1); PG8_STAGE(PG8_SB(1, 0), b3, voffB);
            PG8_BAR; PG8_WAIT_L(0); PG8_MMA(0, 1, At, B1); PG8_BAR;
            PG8_LDA(At, 1, 1); PG8_STAGE(PG8_SA(1, 0), a3, voffA);
            PG8_BAR; PG8_WAIT_L(0); PG8_MMA(1, 0, At, B0); PG8_BAR; PG8_SCHED;
            PG8_STAGE(PG8_SB(1, 1), b3 + hstep, voffB);
            PG8_WAIT_V(6); PG8_BAR; PG8_MMA(1, 1, At, B1); PG8_BAR;
            }
        }
        if constexpr (ALIGN_EPI) { if (wr == 0) PG8_BAR; }
        E(acc, cur, wr, wc, fr, fq); S.done(cur);
        if (!has_next) break;
#pragma unroll
        for (int a = 0; a < 2; ++a)
#pragma unroll
            for (int b = 0; b < 2; ++b)
#pragma unroll
                for (int m = 0; m < 4; ++m)
#pragma unroll
                    for (int n = 0; n < 2; ++n) acc[a][b][m][n] = (f32x4){0.f, 0.f, 0.f, 0.f};
        cur = nxt; cA = nA; cB = nB; ++ui;
        if constexpr (ALIGN_EPI) { if (wr == 1) PG8_BAR; }
    }
    PG8_WAIT_V(0);
    if constexpr (!ALIGN_EPI) { if (wr == 0) PG8_BAR; }
    PG8_BAR;
#undef PG8_SA
#undef PG8_SB
#undef PG8_STAGE
#undef PG8_LDA
#undef PG8_LDB
#undef PG8_MMA
#undef PG8_WAIT_V
#undef PG8_WAIT_L
#undef PG8_BAR
#undef PG8_SCHED
}

struct Epi1 {
    static constexpr bool PERM = true;
    bf16_t *upool, *ulru, *gg, *sgp, *sgl, *ctxp;
    __device__ __forceinline__ void operator()(const Acc& acc, const Unit& u, int wr, int wc, int fr, int fq) const {
        const bool isctx = u.pm >= 64;
        const int sec = u.pn >> 2;
        bf16_t* base = isctx ? ctxp + (size_t)(u.kt0 >> 2) * MC * D : (sec == 0 ? upool : sec == 1 ? ulru : sec == 2 ? gg : sec == 3 ? sgp : sgl);
        const int row0 = (isctx ? u.pm - 64 : u.pm) * BM + wr * 64 + fr, col0 = (u.pn & 3) * BM + wc * 32 + 8 * fq;
#pragma unroll
        for (int ai = 0; ai < 2; ++ai)
#pragma unroll
            for (int m = 0; m < 4; ++m) { bf16_t* rowp = base + (size_t)(row0 + ai * HALF + m * 16) * D + col0;
#pragma unroll
                for (int bj = 0; bj < 2; ++bj) { f32x4 v0 = acc[ai][bj][m][0], v1 = acc[ai][bj][m][1];
                    if (sec == 2) {
#pragma unroll
                        for (int e = 0; e < 4; ++e) { v0[e] = gelu_f(v0[e]); v1[e] = gelu_f(v1[e]); }
                    } else if (sec >= 3) {
#pragma unroll
                        for (int e = 0; e < 4; ++e) { v0[e] = sigmoid_f(v0[e]); v1[e] = sigmoid_f(v1[e]); }
                    }
                    u32x4 o; o.x = cvt_pk_bf16(v0[0], v0[1]); o.y = cvt_pk_bf16(v0[2], v0[3]); o.z = cvt_pk_bf16(v1[0], v1[1]); o.w = cvt_pk_bf16(v1[2], v1[3]);
                    *(u32x4*)(rowp + bj * HALF) = o; } }
    }
};
template <bool SECOND> struct Epi2 {
    static constexpr bool PERM = true;
    const bf16_t* gate; bf16_t* t1m;
    __device__ __forceinline__ void operator()(const Acc& acc, const Unit& u, int wr, int wc, int fr, int fq) const {
        const int row0 = u.pm * BM + wr * 64 + fr, col0 = u.pn * BM + wc * 32 + 8 * fq;
#pragma unroll
        for (int ai = 0; ai < 2; ++ai)
#pragma unroll
            for (int m = 0; m < 4; ++m) { const size_t off = (size_t)(row0 + ai * HALF + m * 16) * D + col0;
#pragma unroll
                for (int bj = 0; bj < 2; ++bj) { const f32x4 v0 = acc[ai][bj][m][0], v1 = acc[ai][bj][m][1];
                    const u32x4 gt = *(const u32x4*)(gate + off + bj * HALF);
                    float r[8];
                    r[0] = bf_lo(gt.x) * v0[0]; r[1] = bf_hi(gt.x) * v0[1]; r[2] = bf_lo(gt.y) * v0[2]; r[3] = bf_hi(gt.y) * v0[3];
                    r[4] = bf_lo(gt.z) * v1[0]; r[5] = bf_hi(gt.z) * v1[1]; r[6] = bf_lo(gt.w) * v1[2]; r[7] = bf_hi(gt.w) * v1[3];
                    if (SECOND) { const u32x4 t = *(const u32x4*)(t1m + off + bj * HALF);
                        r[0] += bf_lo(t.x); r[1] += bf_hi(t.x); r[2] += bf_lo(t.y); r[3] += bf_hi(t.y); r[4] += bf_lo(t.z); r[5] += bf_hi(t.z); r[6] += bf_lo(t.w); r[7] += bf_hi(t.w); }
                    u32x4 o; o.x = cvt_pk_bf16(r[0], r[1]); o.y = cvt_pk_bf16(r[2], r[3]); o.z = cvt_pk_bf16(r[4], r[5]); o.w = cvt_pk_bf16(r[6], r[7]);
                    *(u32x4*)(t1m + off + bj * HALF) = o; } }
    }
};
struct EpiF32 {
    static constexpr bool PERM = false;
    float* C; int ldc;
    __device__ __forceinline__ void operator()(const Acc& acc, const Unit& u, int wr, int wc, int fr, int fq) const {
        const int row0 = u.pm * BM + wr * 64 + fr, col0 = u.pn * BM + wc * 32 + 4 * fq;
#pragma unroll
        for (int ai = 0; ai < 2; ++ai)
#pragma unroll
            for (int m = 0; m < 4; ++m) { float* rowp = C + (size_t)(row0 + ai * HALF + m * 16) * ldc + col0;
#pragma unroll
                for (int bj = 0; bj < 2; ++bj)
#pragma unroll
                    for (int n = 0; n < 2; ++n) *(f32x4*)(rowp + bj * HALF + n * 16) = acc[ai][bj][m][n]; }
    }
};
struct EpiBf16 {
    static constexpr bool PERM = true;
    bf16_t* C; int ldc;
    __device__ __forceinline__ void operator()(const Acc& acc, const Unit& u, int wr, int wc, int fr, int fq) const {
        const int row0 = u.pm * BM + wr * 64 + fr, col0 = u.pn * BM + wc * 32 + 8 * fq;
#pragma unroll
        for (int ai = 0; ai < 2; ++ai)
#pragma unroll
            for (int m = 0; m < 4; ++m) { bf16_t* rowp = C + (size_t)(row0 + ai * HALF + m * 16) * ldc + col0;
#pragma unroll
                for (int bj = 0; bj < 2; ++bj) { const f32x4 v0 = acc[ai][bj][m][0], v1 = acc[ai][bj][m][1];
                    u32x4 o; o.x = cvt_pk_bf16(v0[0], v0[1]); o.y = cvt_pk_bf16(v0[2], v0[3]); o.z = cvt_pk_bf16(v1[0], v1[1]); o.w = cvt_pk_bf16(v1[2], v1[3]);
                    *(u32x4*)(rowp + bj * HALF) = o; } }
    }
};
struct Epi4 {
    static constexpr bool PERM = true;
    bf16_t *g, *u;
    __device__ __forceinline__ void operator()(const Acc& acc, const Unit& un, int wr, int wc, int fr, int fq) const {
        bf16_t* base = un.pn < 12 ? g : u; const int pn = un.pn < 12 ? un.pn : un.pn - 12;
        const int row0 = un.pm * BM + wr * 64 + fr, col0 = pn * BM + wc * 32 + 8 * fq;
#pragma unroll
        for (int ai = 0; ai < 2; ++ai)
#pragma unroll
            for (int m = 0; m < 4; ++m) { bf16_t* rowp = base + (size_t)(row0 + ai * HALF + m * 16) * DFF + col0;
#pragma unroll
                for (int bj = 0; bj < 2; ++bj) { const f32x4 v0 = acc[ai][bj][m][0], v1 = acc[ai][bj][m][1];
                    u32x4 o; o.x = cvt_pk_bf16(v0[0], v0[1]); o.y = cvt_pk_bf16(v0[2], v0[3]); o.z = cvt_pk_bf16(v1[0], v1[1]); o.w = cvt_pk_bf16(v1[2], v1[3]);
                    *(u32x4*)(rowp + bj * HALF) = o; } }
    }
};
}

#define XB_TMO      128
#define XB_XCNT(j)  (256  + 64 * (j))
#define XB_XSUB(j)  (1280 + 64 * (j))
#define XB_XGEN(j)  (2304 + 64 * (j))
#define XB_TOP      3328
#define XB_TOPGEN   3392
#define XCD_BAR_WORDS 3456
#define XB_SPIN_CAP (1u << 18)
__device__ __forceinline__ unsigned xb_ld(unsigned* p)              { return __hip_atomic_load(p, __ATOMIC_RELAXED, __HIP_MEMORY_SCOPE_AGENT); }
__device__ __forceinline__ unsigned xb_add(unsigned* p, unsigned v) { return __hip_atomic_fetch_add(p, v, __ATOMIC_RELAXED, __HIP_MEMORY_SCOPE_AGENT); }
__device__ __forceinline__ unsigned xb_xcc_id() { return (unsigned)__builtin_amdgcn_s_getreg((3 << 11) | 20) & 0xFu; }
#define XB_SPIN(cond, bar) do { unsigned _sp = 0; while (cond) { __builtin_amdgcn_s_sleep(1); \
    if ((++_sp & 255u) == 0u) { if (xb_ld(&(bar)[XB_TMO])) break; if (_sp > XB_SPIN_CAP) { atomicAdd(&(bar)[XB_TMO], 1u); break; } } } } while (0)
struct XcdBarrier { unsigned* bar; unsigned x; volatile LAS unsigned* st; };
__device__ __forceinline__ XcdBarrier xcd_barrier_post(unsigned* bar, volatile LAS unsigned* st) {
    XcdBarrier b; b.bar = bar; b.x = xb_xcc_id(); b.st = st;
    if (threadIdx.x == 0) (void)xb_add(&bar[XB_XCNT(b.x)], 1u);
    return b;
}
__device__ __forceinline__ void xcd_barrier_complete(unsigned* bar, unsigned x, unsigned& nloc, unsigned& nx) {
    const unsigned G = gridDim.x * gridDim.y * gridDim.z;
    unsigned sum, cnt, mine, sp = 0u;
    for (;;) {
        sum = 0u; cnt = 0u; mine = 0u;
#pragma unroll
        for (unsigned j = 0; j < 16; ++j) { const unsigned c = xb_ld(&bar[XB_XCNT(j)]); sum += c; cnt += (c > 0u) ? 1u : 0u; mine = (j == x) ? c : mine; }
        if (sum == G) break;
        __builtin_amdgcn_s_sleep(1);
        if ((++sp & 255u) == 0u) { if (xb_ld(&bar[XB_TMO])) break; if (sp > XB_SPIN_CAP) { atomicAdd(&bar[XB_TMO], 1u); break; } }
    }
    nloc = mine > 0u ? mine : 1u; nx = cnt > 0u ? cnt : 1u;
}
__device__ __forceinline__ void xcd_barrier(const XcdBarrier& b) {
    asm volatile("s_waitcnt vmcnt(0)" ::: "memory");
    __syncthreads();
    if (threadIdx.x == 0) {
        unsigned* bar = b.bar;
        __builtin_amdgcn_s_waitcnt(0);
        unsigned nloc = b.st[0], nx = b.st[1];
        if (nloc == 0u) { xcd_barrier_complete(bar, b.x, nloc, nx); b.st[0] = nloc; b.st[1] = nx; }
        const unsigned old = xb_add(&bar[XB_XSUB(b.x)], 1u);
        const unsigned gen = old / nloc;
        if (old + 1u == (gen + 1u) * nloc) {
            __builtin_amdgcn_fence(__ATOMIC_RELEASE, "agent");
            asm volatile("s_waitcnt vmcnt(0)" ::: "memory");
            const unsigned og = xb_add(&bar[XB_TOP], 1u);
            const unsigned tg = og / nx;
            if (og + 1u == (tg + 1u) * nx) xb_add(&bar[XB_TOPGEN], 1u);
            else XB_SPIN(xb_ld(&bar[XB_TOPGEN]) == tg, bar);
            __builtin_amdgcn_fence(__ATOMIC_ACQUIRE, "agent");
            xb_add(&bar[XB_XGEN(b.x)], 1u);
            asm volatile("s_waitcnt vmcnt(0)" ::: "memory");
        } else {
            XB_SPIN(xb_ld(&bar[XB_XGEN(b.x)]) == gen, bar);
            __builtin_amdgcn_fence(__ATOMIC_ACQUIRE, "agent");
            asm volatile("s_waitcnt vmcnt(0)" ::: "memory");
        }
    }
    __syncthreads();
}
constexpr int MISC_OFF = 139264;
constexpr size_t CTL_BYTES = 16384;

struct Args { const float* in[27]; float* out; unsigned char* ws; int ph_lo, ph_hi; };

struct TItem { const float* W; bf16_t* WT; int K, N, item; };
__device__ __forceinline__ void transpose_load(const TItem& t, int lane, f32x4 (&v)[8]) {
    const int nblk = t.N / 32, kb = t.item / nblk, nb = t.item % nblk, k0 = 64 * kb, n0 = 32 * nb;
    const int kr = lane >> 3, n4 = (lane & 7) * 4;
#pragma unroll
    for (int i = 0; i < 8; ++i) v[i] = *(const f32x4*)(t.W + (size_t)(k0 + i * 8 + kr) * t.N + n0 + n4);
}
__device__ __forceinline__ void transpose_store(const TItem& t, int lane, const f32x4 (&v)[8], LAS float* scr) {
    const int nblk = t.N / 32, kb = t.item / nblk, nb = t.item % nblk, k0 = 64 * kb, n0 = 32 * nb;
    const int kr = lane >> 3, n4 = (lane & 7) * 4;
#pragma unroll
    for (int i = 0; i < 8; ++i) { LAS float* d = scr + (i * 8 + kr) * 33 + n4; d[0] = v[i].x; d[1] = v[i].y; d[2] = v[i].z; d[3] = v[i].w; }
    LDS_WAIT();
    const int c = lane & 7;
#pragma unroll
    for (int j = 0; j < 4; ++j) { const int n = (lane >> 3) + 8 * j; const LAS float* s = scr + (8 * c) * 33 + n;
        u32x4 o; o.x = cvt_pk_bf16(s[0 * 33], s[1 * 33]); o.y = cvt_pk_bf16(s[2 * 33], s[3 * 33]); o.z = cvt_pk_bf16(s[4 * 33], s[5 * 33]); o.w = cvt_pk_bf16(s[6 * 33], s[7 * 33]);
        *(u32x4*)(t.WT + (size_t)(n0 + n) * t.K + k0 + 8 * c) = o; }
    LDS_WAIT();
}

__device__ __forceinline__ void p0_prep(const Args& a, LAS unsigned char* lds, int tid, int lane, int wave, int G) {
    unsigned char* ws = a.ws;
    {
        LAS float* s = (LAS float*)lds; LAS float* part = (LAS float*)(lds + 36864);
        const float* c = a.in[1]; const float* cc = a.in[3]; const float* wm = a.in[4]; const float* bm = a.in[5];
        float* mod = (float*)(ws + WS_MOD);
        bool have = false;
        for (int bi = blockIdx.x; bi < 192; bi += G) {
            if (!have) { for (int idx = tid; idx < 9 * 1024; idx += 512) { const int r = idx >> 10, k = idx & 1023; const float v = (r < 8) ? c[r * 1024 + k] : cc[k]; s[idx] = v * sigmoid_f(v); } have = true; }
            __syncthreads();
            const int q = tid & 7, ks = tid >> 3, j = bi * 32 + 4 * q;
            f32x4 w[16];
#pragma unroll
            for (int kk = 0; kk < 16; ++kk) w[kk] = *(const f32x4*)(wm + (size_t)(ks * 16 + kk) * 6144 + j);
            f32x4 acc[9];
#pragma unroll
            for (int r = 0; r < 9; ++r) acc[r] = (f32x4){0.f, 0.f, 0.f, 0.f};
#pragma unroll
            for (int kk = 0; kk < 16; ++kk) {
#pragma unroll
                for (int r = 0; r < 9; ++r) acc[r] += s[r * 1024 + ks * 16 + kk] * w[kk]; }
#pragma unroll
            for (int r = 0; r < 9; ++r) *(LAS f32x4*)(part + ((ks * 9 + r) * 32 + 4 * q)) = acc[r];
            __syncthreads();
            if (tid < 288) { const int r = tid >> 5, col = tid & 31; float sum = bm[bi * 32 + col];
                for (int k2 = 0; k2 < 64; ++k2) sum += part[(k2 * 9 + r) * 32 + col];
                mod[r * 6144 + bi * 32 + col] = sum; }
            __syncthreads();
        }
    }
    {
        const float* pw = a.in[11]; const float* psc = a.in[12]; const float* wpp = a.in[20];
        bf16_t* wt = (bf16_t*)(ws + WS_WPP);
        LAS float* PWt = (LAS float*)lds; LAS float* WPs = (LAS float*)(lds + 65536);
        for (int fi = blockIdx.x; fi < 256; fi += G) {
            const int g = fi >> 6, ib = (fi >> 4) & 3, nbk = fi & 15;
#pragma unroll
            for (int t = 0; t < 8; ++t) { const int idx = tid + 512 * t, i = idx & 63, j4 = idx >> 6;
                const f32x4 v = *(const f32x4*)(pw + (size_t)(g * 256 + ib * 64 + i) * 256 + 4 * j4);
                PWt[(4 * j4 + 0) * 64 + i] = v.x; PWt[(4 * j4 + 1) * 64 + i] = v.y; PWt[(4 * j4 + 2) * 64 + i] = v.z; PWt[(4 * j4 + 3) * 64 + i] = v.w; }
#pragma unroll
            for (int t = 0; t < 8; ++t) { const int idx = tid + 512 * t, j = idx >> 4, n4 = idx & 15;
                const f32x4 v = *(const f32x4*)(wpp + (size_t)(g * 256 + j) * 1024 + nbk * 64 + 4 * n4) * psc[g * 256 + j];
                *(LAS f32x4*)(WPs + j * 64 + 4 * n4) = v; }
            __syncthreads();
            const int tn = tid & 31, ti = tid >> 5;
            f32x4 acc0 = (f32x4){0.f, 0.f, 0.f, 0.f}, acc1 = (f32x4){0.f, 0.f, 0.f, 0.f};
#pragma unroll 8
            for (int j = 0; j < 256; ++j) { const f32x4 av = *(const LAS f32x4*)(PWt + j * 64 + 4 * ti); const f32x2 bv = *(const LAS f32x2*)(WPs + j * 64 + 2 * tn);
                acc0 += av * bv.x; acc1 += av * bv.y; }
            const int n = nbk * 64 + 2 * tn, k0 = g * 256 + ib * 64 + 4 * ti;
            u32x2 o0, o1; o0.x = cvt_pk_bf16(acc0.x, acc0.y); o0.y = cvt_pk_bf16(acc0.z, acc0.w); o1.x = cvt_pk_bf16(acc1.x, acc1.y); o1.y = cvt_pk_bf16(acc1.z, acc1.w);
            *(u32x2*)(wt + (size_t)n * 1024 + k0) = o0; *(u32x2*)(wt + (size_t)(n + 1) * 1024 + k0) = o1;
            __syncthreads();
        }
    }
    {
        LAS float* scr = (LAS float*)(lds + wave * 16384);
        const int gw = (G - 1 - (int)blockIdx.x) * 8 + wave, NGW = G * 8;
        constexpr int I_IN = 16 * 160, I_LP = 16 * 32, I_OUT = 16 * 32, I_UP = 16 * 192, I_DN = 48 * 32, I_C = 32 * 8;
        constexpr int NIT = I_IN + I_LP + I_OUT + I_UP + I_DN + I_C;
        auto decode = [&](int it) -> TItem {
            int r = it;
            if (r < I_IN) return TItem{a.in[10], (bf16_t*)(ws + WS_WIN), 1024, DIN, r}; r -= I_IN;
            if (r < I_LP) return TItem{a.in[21], (bf16_t*)(ws + WS_WLP), 1024, 1024, r}; r -= I_LP;
            if (r < I_OUT) return TItem{a.in[22], (bf16_t*)(ws + WS_WOUT), 1024, 1024, r}; r -= I_OUT;
            if (r < I_UP) return TItem{a.in[23], (bf16_t*)(ws + WS_WUP), 1024, 2 * DFF, r}; r -= I_UP;
            if (r < I_DN) return TItem{a.in[26], (bf16_t*)(ws + WS_WDOWN), DFF, 1024, r}; r -= I_DN;
            const int mat = r >> 3, sub = r & 7, dir = mat >> 4, ax = (mat >> 3) & 1, blk = mat & 7;
            return TItem{(ax ? a.in[17] : a.in[15]) + (size_t)(dir * 8 + blk) * 16384, (bf16_t*)(ws + WS_WC) + (size_t)mat * 16384, 128, 128, sub};
        };
        for (int it = gw; it < NIT; it += 2 * NGW) {
            const TItem ta = decode(it); f32x4 va[8]; transpose_load(ta, lane, va);
            const bool two = it + NGW < NIT;
            const TItem tb = decode(two ? it + NGW : it); f32x4 vb[8];
            if (two) transpose_load(tb, lane, vb);
            transpose_store(ta, lane, va, scr);
            if (two) transpose_store(tb, lane, vb, scr);
        }
    }
}

__device__ __forceinline__ void p1_norm1(const Args& a, int lane, int gw, int NGW) {
    const float* mod = (const float*)(a.ws + WS_MOD); const float* gpre = a.in[6]; bf16_t* hx = (bf16_t*)(a.ws + WS_HX);
    f32x4 g4[4];
#pragma unroll
    for (int j = 0; j < 4; ++j) g4[j] = *(const f32x4*)(gpre + 4 * (lane + 64 * j));
    constexpr int NR = 9, PF = 3;
    for (int c = gw; c < MT / NR; c += NGW) {
        const int m0 = c * NR;
        const int mrA = m0 < M ? (m0 >> 11) : 8, mrB = (m0 + NR - 1) < M ? ((m0 + NR - 1) >> 11) : 8;
        f32x4 sA[4], hA[4], sB[4], hB[4];
#pragma unroll
        for (int j = 0; j < 4; ++j) { const int col = 4 * (lane + 64 * j);
            hA[j] = *(const f32x4*)(mod + mrA * 6144 + col); sA[j] = *(const f32x4*)(mod + mrA * 6144 + 1024 + col);
            hB[j] = *(const f32x4*)(mod + mrB * 6144 + col); sB[j] = *(const f32x4*)(mod + mrB * 6144 + 1024 + col); }
        f32x4 v[NR][4];
#define P1_LOAD(r_) do { const int mm = m0 + (r_); const float* src = mm < M ? a.in[0] + (size_t)mm * D : a.in[2] + (size_t)(mm - M) * D; \
            _Pragma("unroll") for (int j = 0; j < 4; ++j) v[r_][j] = ((const f32x4*)src)[lane + 64 * j]; } while (0)
#pragma unroll
        for (int r = 0; r < PF; ++r) P1_LOAD(r);
#pragma unroll
        for (int r = 0; r < NR; ++r) {
            asm volatile("" ::: "memory");
            if (r + PF < NR) P1_LOAD(r + PF);
            asm volatile("" ::: "memory");
            const int m = m0 + r; const bool useA = (m < M ? (m >> 11) : 8) == mrA;
            float ss = 0.f;
#pragma unroll
            for (int j = 0; j < 4; ++j) ss += (v[r][j].x * v[r][j].x + v[r][j].y * v[r][j].y) + (v[r][j].z * v[r][j].z + v[r][j].w * v[r][j].w);
            const float rstd = rsqrtf(wave_sum(ss) * (1.f / D) + EPS);
#pragma unroll
            for (int j = 0; j < 4; ++j) { const int col = 4 * (lane + 64 * j);
                const f32x4 s4 = useA ? sA[j] : sB[j], h4 = useA ? hA[j] : hB[j];
                const f32x4 y = v[r][j] * rstd * g4[j] * (1.f + s4) + h4;
                u32x2 o; o.x = cvt_pk_bf16(y.x, y.y); o.y = cvt_pk_bf16(y.z, y.w);
                *(u32x2*)(hx + (size_t)m * D + col) = o; }
        }
#undef P1_LOAD
    }
}

constexpr int PROW = 4160;
template <int HW>
__device__ __forceinline__ void pool_body(LAS unsigned char* img, const bf16_t* up, bf16_t* dp, int b, int ch0, int tid) {
    {
        const int r = tid >> 4, cp = tid & 15;
        LAS unsigned char* rowb = img + r * PROW + cp * 4;
        unsigned v[64];
#pragma unroll
        for (int c = 0; c < 64; ++c) v[c] = *(LAS unsigned*)(rowb + c * 64);
        float slo = 0.f, shi = 0.f;
#pragma unroll
        for (int c = 0; c < HW; ++c) { slo += bf_lo(v[c]); shi += bf_hi(v[c]); }
#pragma unroll
        for (int c = 0; c < 64; ++c) {
            *(LAS unsigned*)(rowb + c * 64) = cvt_pk_bf16(slo, shi);
            if (c + HW < 64) { slo += bf_lo(v[c + HW]); shi += bf_hi(v[c + HW]); }
            if (c - HW >= 0) { slo -= bf_lo(v[c - HW]); shi -= bf_hi(v[c - HW]); }
        }
    }
    __syncthreads();
#pragma unroll
    for (int j = 0; j < 2; ++j) {
        const int p = tid + 512 * j, cp = p & 15, c = p >> 4;
        LAS unsigned char* colb = img + c * 64 + cp * 4;
        unsigned v[32];
#pragma unroll
        for (int r = 0; r < 32; ++r) v[r] = *(LAS unsigned*)(colb + r * PROW);
        const int clo = c - HW < 0 ? 0 : c - HW, chi = c + HW > 64 ? 64 : c + HW;
        const float ccnt = (float)(chi - clo);
        float slo = 0.f, shi = 0.f;
#pragma unroll
        for (int r = 0; r < HW; ++r) { slo += bf_lo(v[r]); shi += bf_hi(v[r]); }
#pragma unroll
        for (int r = 0; r < 32; ++r) {
            const int rlo = r - HW < 0 ? 0 : r - HW, rhi = r + HW > 32 ? 32 : r + HW;
            const float inv = 1.f / (ccnt * (float)(rhi - rlo));
            const size_t gi = (size_t)(b * SEQL + r * 64 + c) * D + ch0 + 2 * cp;
            const unsigned uu = *(const unsigned*)(up + gi);
            *(unsigned*)(dp + gi) = cvt_pk_bf16(slo * inv - bf_lo(uu), shi * inv - bf_hi(uu));
            if (r + HW < 32) { slo += bf_lo(v[r + HW]); shi += bf_hi(v[r + HW]); }
            if (r - HW >= 0) { slo -= bf_lo(v[r - HW]); shi -= bf_hi(v[r - HW]); }
        }
    }
}
__device__ __forceinline__ void p3_pool(const Args& a, LAS unsigned char* lds, int tid, int G) {
    const bf16_t* up = (const bf16_t*)(a.ws + WS_UPOOL); bf16_t* dp = (bf16_t*)(a.ws + WS_DP);
    for (int pi = blockIdx.x; pi < 256; pi += G) {
        const int b = pi >> 5, slab = pi & 31, ch0 = slab * 32, grp = slab >> 3;
#pragma unroll 4
        for (int i = 0; i < 16; ++i) { const int idx = tid + 512 * i, tok = idx >> 2, part = idx & 3;
            const u32x4 val = *(const u32x4*)(up + (size_t)(b * SEQL + tok) * D + ch0 + part * 8);
            *(LAS u32x4*)(lds + (tok >> 6) * PROW + (tok & 63) * 64 + part * 16) = val; }
        __syncthreads();
        if (grp == 0) pool_body<1>(lds, up, dp, b, ch0, tid);
        else if (grp == 1) pool_body<2>(lds, up, dp, b, ch0, tid);
        else if (grp == 2) pool_body<4>(lds, up, dp, b, ch0, tid);
        else pool_body<8>(lds, up, dp, b, ch0, tid);
        __syncthreads();
    }
}

constexpr int LA_STRIDE = 272;
constexpr int LA_BYTES = 128 * LA_STRIDE;
constexpr int LS_OFF = LA_BYTES;
constexpr int HS_STRIDE = 132;

template <bool FINAL>
__device__ __forceinline__ void lru_item(const Args& a, LAS unsigned char* lds, int b, int q, int nb, int tid, int lane, int wave) {
    unsigned char* ws = a.ws;
    const bf16_t* ulru = (const bf16_t*)(ws + WS_ULRU);
    const bool isctx = q < 2;
    const int t0 = isctx ? q * 128 : (q - 2) * 128;
    const int seglen = isctx ? CTXL : SEQL;
    const size_t rowbase = isctx ? (size_t)(M + b * CTXL) : (size_t)(b * SEQL);
    {
        const int cg8 = tid & 15, tr = tid >> 4, ch = nb * 128 + cg8 * 8;
        const float* cw = a.in[13]; const float* cb = a.in[14];
        float wv[4][8], bias[8];
#pragma unroll
        for (int k = 0; k < 4; ++k) { const f32x4 w0 = *(const f32x4*)(cw + k * 1024 + ch), w1 = *(const f32x4*)(cw + k * 1024 + ch + 4);
            wv[k][0] = w0.x; wv[k][1] = w0.y; wv[k][2] = w0.z; wv[k][3] = w0.w; wv[k][4] = w1.x; wv[k][5] = w1.y; wv[k][6] = w1.z; wv[k][7] = w1.w; }
        { const f32x4 b0 = *(const f32x4*)(cb + ch), b1 = *(const f32x4*)(cb + ch + 4);
          bias[0] = b0.x; bias[1] = b0.y; bias[2] = b0.z; bias[3] = b0.w; bias[4] = b1.x; bias[5] = b1.y; bias[6] = b1.z; bias[7] = b1.w; }
        float ur[7][8];
        if (!FINAL && isctx) {
            const bf16_t* cp = (const bf16_t*)(ws + WS_CTXP);
#pragma unroll
            for (int i = 0; i < 7; ++i) { const int tok = t0 + tr * 4 - 2 + i;
#pragma unroll
                for (int e = 0; e < 8; ++e) ur[i][e] = 0.f;
                if (tok >= 0 && tok < seglen) {
#pragma unroll
                    for (int p = 0; p < 4; ++p) { const u32x4 val = *(const u32x4*)(cp + ((size_t)p * MC + b * CTXL + tok) * D + ch);
                        ur[i][0] += bf_lo(val.x); ur[i][1] += bf_hi(val.x); ur[i][2] += bf_lo(val.y); ur[i][3] += bf_hi(val.y);
                        ur[i][4] += bf_lo(val.z); ur[i][5] += bf_hi(val.z); ur[i][6] += bf_lo(val.w); ur[i][7] += bf_hi(val.w); } } }
        } else {
#pragma unroll
        for (int i = 0; i < 7; ++i) { const int tok = t0 + tr * 4 - 2 + i;
            u32x4 val = (u32x4){0u, 0u, 0u, 0u};
            if (tok >= 0 && tok < seglen) val = *(const u32x4*)(ulru + (rowbase + tok) * D + ch);
            ur[i][0] = bf_lo(val.x); ur[i][1] = bf_hi(val.x); ur[i][2] = bf_lo(val.y); ur[i][3] = bf_hi(val.y);
            ur[i][4] = bf_lo(val.z); ur[i][5] = bf_hi(val.z); ur[i][6] = bf_lo(val.w); ur[i][7] = bf_hi(val.w); }
        }
#pragma unroll
        for (int tk = 0; tk < 4; ++tk) { float xc[8];
#pragma unroll
            for (int e = 0; e < 8; ++e) { float s = bias[e];
#pragma unroll
                for (int k = 0; k < 4; ++k) s += ur[tk + k][e] * wv[k][e];
                xc[e] = s; }
            u32x4 o; o.x = cvt_pk_bf16(xc[0], xc[1]); o.y = cvt_pk_bf16(xc[2], xc[3]); o.z = cvt_pk_bf16(xc[4], xc[5]); o.w = cvt_pk_bf16(xc[6], xc[7]);
            *(LAS u32x4*)(lds + (tr * 4 + tk) * LA_STRIDE + cg8 * 16) = o; }
    }
    __syncthreads();
    const int dir = wave >> 2, cq = wave & 3, r32 = lane & 31, h = lane >> 5;
    const int chl = cq * 32 + r32, ch = nb * 128 + chl;
    f32x16 accA[4], accX[4];
    {
        const bf16_t* wc = (const bf16_t*)(ws + WS_WC);
        const bf16_t* wa = wc + ((size_t)((dir * 2 + 0) * 8 + nb) * 128 + chl) * 128 + h * 8;
        const bf16_t* wx = wc + ((size_t)((dir * 2 + 1) * 8 + nb) * 128 + chl) * 128 + h * 8;
        bf16x8 Ba[8], Bx[8];
#pragma unroll
        for (int ks = 0; ks < 8; ++ks) { Ba[ks] = *(const bf16x8*)(wa + ks * 16); Bx[ks] = *(const bf16x8*)(wx + ks * 16); }
        const float lam = a.in[19][dir * 1024 + ch], ba = a.in[16][dir * 1024 + ch], bx = a.in[18][dir * 1024 + ch];
        const float sp = log1pf(__expf(-lam));
        const float k2 = -8.f * sp * 1.4426950409f;
#define LRU_MFMA_TILE(tt) do { _Pragma("unroll") for (int i = 0; i < 16; ++i) { accA[tt][i] = 0.f; accX[tt][i] = 0.f; } \
        _Pragma("unroll") for (int ks = 0; ks < 8; ++ks) { \
            const bf16x8 Af = *(const LAS bf16x8*)(lds + ((tt) * 32 + r32) * LA_STRIDE + (ks * 16 + h * 8) * 2); \
            accA[tt] = __builtin_amdgcn_mfma_f32_32x32x16_bf16(Af, Ba[ks], accA[tt], 0, 0, 0); \
            accX[tt] = __builtin_amdgcn_mfma_f32_32x32x16_bf16(Af, Bx[ks], accX[tt], 0, 0, 0); } } while (0)
        LAS f32x2* Sg = (LAS f32x2*)(lds + LS_OFF) + (wave * 32 + r32) * 33;
#define LRU_COEF_TILE(tt) do { _Pragma("unroll") for (int i = 0; i < 16; ++i) { \
            const int tokl = (tt) * 32 + (i & 3) + 8 * (i >> 2) + 4 * h; \
            const float xcv = bf2f(*(const LAS bf16_t*)(lds + tokl * LA_STRIDE + chl * 2)); \
            const float r = sigmoid_f(accA[tt][i] + ba), ii = sigmoid_f(accX[tt][i] + bx); \
            const float av = __builtin_amdgcn_exp2f(k2 * r); \
            const float mult = __builtin_amdgcn_sqrtf(fmaxf(1.f - av * av, 0.f)); \
            accA[tt][i] = av; accX[tt][i] = mult * ii * xcv; } } while (0)
#define LRU_SUM_TILE(tt) do { _Pragma("unroll") for (int j = 0; j < 4; ++j) { \
            const float a0 = accA[tt][4 * j], a1 = accA[tt][4 * j + 1], a2 = accA[tt][4 * j + 2], a3 = accA[tt][4 * j + 3]; \
            const float b0 = accX[tt][4 * j], b1 = accX[tt][4 * j + 1], b2 = accX[tt][4 * j + 2], b3 = accX[tt][4 * j + 3]; \
            f32x2 s; s.x = (a0 * a1) * (a2 * a3); \
            s.y = dir == 0 ? ((b0 * a1 + b1) * a2 + b2) * a3 + b3 : ((b3 * a2 + b2) * a1 + b1) * a0 + b0; \
            Sg[(tt) * 8 + j * 2 + h] = s; } } while (0)
        if constexpr (!FINAL) {
            LRU_MFMA_TILE(0);
            __builtin_amdgcn_sched_barrier(0); LRU_MFMA_TILE(1); __builtin_amdgcn_sched_barrier(0); LRU_COEF_TILE(0); LRU_SUM_TILE(0);
            __builtin_amdgcn_sched_barrier(0); LRU_MFMA_TILE(2); __builtin_amdgcn_sched_barrier(0); LRU_COEF_TILE(1); LRU_SUM_TILE(1);
            __builtin_amdgcn_sched_barrier(0); LRU_MFMA_TILE(3); __builtin_amdgcn_sched_barrier(0); LRU_COEF_TILE(2); LRU_SUM_TILE(2);
            __builtin_amdgcn_sched_barrier(0); LRU_COEF_TILE(3); LRU_SUM_TILE(3);
        } else {
            LRU_MFMA_TILE(0);
            __builtin_amdgcn_sched_barrier(0); LRU_MFMA_TILE(1); __builtin_amdgcn_sched_barrier(0); LRU_COEF_TILE(0); LRU_SUM_TILE(0);
            __builtin_amdgcn_sched_barrier(0); LRU_MFMA_TILE(2); __builtin_amdgcn_sched_barrier(0); LRU_COEF_TILE(1); LRU_SUM_TILE(1);
            __builtin_amdgcn_sched_barrier(0); LRU_MFMA_TILE(3); __builtin_amdgcn_sched_barrier(0); LRU_COEF_TILE(2); LRU_SUM_TILE(2);
            __builtin_amdgcn_sched_barrier(0); LRU_COEF_TILE(3); LRU_SUM_TILE(3);
        }
#undef LRU_MFMA_TILE
#undef LRU_COEF_TILE
#undef LRU_SUM_TILE
    }
    LAS f32x2* Sg = (LAS f32x2*)(lds + LS_OFF) + (wave * 32 + r32) * 33;
    LDS_WAIT();
    f32x2* sum = (f32x2*)(ws + WS_SUM);
    if (h == 0) {
        float hc = 0.f;
        if (FINAL) {
            const int cnt = dir == 0 ? q : 2 + (NCHUNK - 1 - q);
#pragma unroll
            for (int k0 = 0; k0 < 20; k0 += 10) {
                f32x2 cs[10];
#pragma unroll
                for (int kk = 0; kk < 10; ++kk) { const int k = k0 + kk; const int c = dir == 0 ? k : (k == 0 ? 1 : (k == 1 ? 0 : NCHUNK + 1 - k));
                    cs[kk] = (f32x2){1.f, 0.f}; if (k < cnt) cs[kk] = sum[(size_t)((b * NCHUNK + c) * 2 + dir) * 1024 + ch]; }
#pragma unroll
                for (int kk = 0; kk < 10; ++kk) hc = cs[kk].x * hc + cs[kk].y;
            }
        }
        float pt = 1.f;
        if (dir == 0) {
#pragma unroll 8
            for (int g = 0; g < 32; ++g) { const f32x2 s = Sg[g]; if (FINAL) Sg[g].x = hc; hc = s.x * hc + s.y; pt *= s.x; }
        } else {
#pragma unroll 8
            for (int g = 31; g >= 0; --g) { const f32x2 s = Sg[g]; if (FINAL) Sg[g].x = hc; hc = s.x * hc + s.y; pt *= s.x; }
        }
        if (!FINAL) { f32x2 s; s.x = pt; s.y = hc; sum[(size_t)((b * NCHUNK + q) * 2 + dir) * 1024 + ch] = s; }
    }
    if (FINAL) {
        LDS_WAIT();
#pragma unroll
        for (int tt = 0; tt < 4; ++tt)
#pragma unroll
            for (int j = 0; j < 4; ++j) {
                float hh = Sg[tt * 8 + j * 2 + h].x;
                if (dir == 0) {
#pragma unroll
                    for (int k = 0; k < 4; ++k) { hh = accA[tt][4 * j + k] * hh + accX[tt][4 * j + k]; accX[tt][4 * j + k] = hh; }
                } else {
#pragma unroll
                    for (int k = 3; k >= 0; --k) { hh = accA[tt][4 * j + k] * hh + accX[tt][4 * j + k]; accX[tt][4 * j + k] = hh; }
                }
            }
        u32x4 gvp[4];
        { const int cg8 = tid & 15, tr = tid >> 4; const bf16_t* gg = (const bf16_t*)(ws + WS_GG);
#pragma unroll
          for (int tk = 0; tk < 4; ++tk) gvp[tk] = *(const u32x4*)(gg + (size_t)(b * SEQL + t0 + tr * 4 + tk) * D + nb * 128 + cg8 * 8); }
        __syncthreads();
        LAS float* hs = (LAS float*)(lds + LS_OFF);
        if (dir == 0) {
#pragma unroll
            for (int tt = 0; tt < 4; ++tt)
#pragma unroll
                for (int i = 0; i < 16; ++i) hs[(tt * 32 + (i & 3) + 8 * (i >> 2) + 4 * h) * HS_STRIDE + chl] = accX[tt][i];
        }
        __syncthreads();
        if (dir == 1) {
#pragma unroll
            for (int tt = 0; tt < 4; ++tt)
#pragma unroll
                for (int i = 0; i < 16; ++i) hs[(tt * 32 + (i & 3) + 8 * (i >> 2) + 4 * h) * HS_STRIDE + chl] += accX[tt][i];
        }
        __syncthreads();
        {
            const int cg8 = tid & 15, tr = tid >> 4;
            const bf16_t* gg = (const bf16_t*)(ws + WS_GG); bf16_t* yl = (bf16_t*)(ws + WS_YLRU);
#pragma unroll
            for (int tk = 0; tk < 4; ++tk) { const int tokl = tr * 4 + tk;
                const f32x4 h0 = *(const LAS f32x4*)(hs + tokl * HS_STRIDE + cg8 * 8), h1 = *(const LAS f32x4*)(hs + tokl * HS_STRIDE + cg8 * 8 + 4);
                const size_t gi = (size_t)(b * SEQL + t0 + tokl) * D + nb * 128 + cg8 * 8;
                const u32x4 gv = gvp[tk];
                u32x4 o; o.x = cvt_pk_bf16(h0.x * bf_lo(gv.x), h0.y * bf_hi(gv.x)); o.y = cvt_pk_bf16(h0.z * bf_lo(gv.y), h0.w * bf_hi(gv.y));
                o.z = cvt_pk_bf16(h1.x * bf_lo(gv.z), h1.y * bf_hi(gv.z)); o.w = cvt_pk_bf16(h1.z * bf_lo(gv.w), h1.w * bf_hi(gv.w));
                *(u32x4*)(yl + gi) = o; }
        }
    }
    __syncthreads();
}

__device__ __forceinline__ void p8_norm2(const Args& a, int lane, int gw, int NGW) {
    const float* mod = (const float*)(a.ws + WS_MOD); const bf16_t* mix = (const bf16_t*)(a.ws + WS_MIX);
    const float* gpm = a.in[7]; const float* gpf = a.in[8]; bf16_t* h2 = (bf16_t*)(a.ws + WS_H2);
    constexpr int NR = 8, PF = 2;
    for (int grp = gw; grp < M / NR; grp += NGW) {
        const int m0 = grp * NR; const float* mb = mod + (m0 >> 11) * 6144;
        f32x4 g1[4], ga[4], g2[4], sc[4], sh[4];
#pragma unroll
        for (int j = 0; j < 4; ++j) { const int col = 4 * (lane + 64 * j); g1[j] = *(const f32x4*)(gpm + col); ga[j] = *(const f32x4*)(mb + 2048 + col);
            g2[j] = *(const f32x4*)(gpf + col); sc[j] = *(const f32x4*)(mb + 4096 + col); sh[j] = *(const f32x4*)(mb + 3072 + col); }
        u32x2 vb[NR][4]; f32x4 xv[NR][4];
#define P8_LOAD(r_) do { _Pragma("unroll") for (int j = 0; j < 4; ++j) { vb[r_][j] = *(const u32x2*)(mix + (size_t)(m0 + (r_)) * D + 4 * (lane + 64 * j)); \
            xv[r_][j] = ((const f32x4*)(a.in[0] + (size_t)(m0 + (r_)) * D))[lane + 64 * j]; } } while (0)
#pragma unroll
        for (int r = 0; r < PF; ++r) P8_LOAD(r);
#pragma unroll
        for (int r = 0; r < NR; ++r) {
            asm volatile("" ::: "memory");
            if (r + PF < NR) P8_LOAD(r + PF);
            asm volatile("" ::: "memory");
            const int m = m0 + r;
            f32x4 v[4]; float ss = 0.f;
#pragma unroll
            for (int j = 0; j < 4; ++j) { v[j] = (f32x4){bf_lo(vb[r][j].x), bf_hi(vb[r][j].x), bf_lo(vb[r][j].y), bf_hi(vb[r][j].y)};
                ss += (v[j].x * v[j].x + v[j].y * v[j].y) + (v[j].z * v[j].z + v[j].w * v[j].w); }
            const float rstd = rsqrtf(wave_sum(ss) * (1.f / D) + EPS);
            float s2 = 0.f; f32x4 x1[4];
#pragma unroll
            for (int j = 0; j < 4; ++j) { x1[j] = xv[r][j] + ga[j] * (v[j] * rstd * g1[j]);
                *(f32x4*)(a.out + (size_t)m * D + 4 * (lane + 64 * j)) = x1[j];
                s2 += (x1[j].x * x1[j].x + x1[j].y * x1[j].y) + (x1[j].z * x1[j].z + x1[j].w * x1[j].w); }
            const float rstd2 = rsqrtf(wave_sum(s2) * (1.f / D) + EPS);
#pragma unroll
            for (int j = 0; j < 4; ++j) { const f32x4 y = x1[j] * rstd2 * g2[j] * (1.f + sc[j]) + sh[j];
                u32x2 o; o.x = cvt_pk_bf16(y.x, y.y); o.y = cvt_pk_bf16(y.z, y.w);
                *(u32x2*)(h2 + (size_t)m * D + 4 * (lane + 64 * j)) = o; }
        }
#undef P8_LOAD
    }
}
__device__ __forceinline__ void p12_final(const Args& a, int lane, int gw, int NGW) {
    const float* mod = (const float*)(a.ws + WS_MOD); const bf16_t* fx = (const bf16_t*)(a.ws + WS_FX); const float* gpo = a.in[9];
    constexpr int NR = 8, PF = 3;
    for (int grp = gw; grp < M / NR; grp += NGW) {
        const int m0 = grp * NR; const float* mb = mod + (m0 >> 11) * 6144;
        f32x4 g4[4], ga[4];
#pragma unroll
        for (int j = 0; j < 4; ++j) { const int col = 4 * (lane + 64 * j); g4[j] = *(const f32x4*)(gpo + col); ga[j] = *(const f32x4*)(mb + 5120 + col); }
        u32x2 vb[NR][4]; f32x4 xv[NR][4];
#define P12_LOAD(r_) do { _Pragma("unroll") for (int j = 0; j < 4; ++j) { vb[r_][j] = *(const u32x2*)(fx + (size_t)(m0 + (r_)) * D + 4 * (lane + 64 * j)); \
            xv[r_][j] = ((const f32x4*)(a.out + (size_t)(m0 + (r_)) * D))[lane + 64 * j]; } } while (0)
#pragma unroll
        for (int r = 0; r < PF; ++r) P12_LOAD(r);
#pragma unroll
        for (int r = 0; r < NR; ++r) {
            asm volatile("" ::: "memory");
            if (r + PF < NR) P12_LOAD(r + PF);
            asm volatile("" ::: "memory");
            const int m = m0 + r;
            f32x4 v[4]; float ss = 0.f;
#pragma unroll
            for (int j = 0; j < 4; ++j) { v[j] = (f32x4){bf_lo(vb[r][j].x), bf_hi(vb[r][j].x), bf_lo(vb[r][j].y), bf_hi(vb[r][j].y)};
                ss += (v[j].x * v[j].x + v[j].y * v[j].y) + (v[j].z * v[j].z + v[j].w * v[j].w); }
            const float rstd = rsqrtf(wave_sum(ss) * (1.f / D) + EPS);
#pragma unroll
            for (int j = 0; j < 4; ++j) *(f32x4*)(a.out + (size_t)m * D + 4 * (lane + 64 * j)) = xv[r][j] + ga[j] * (v[j] * rstd * g4[j]);
        }
#undef P12_LOAD
    }
}

__device__ __forceinline__ void p10_conv(const Args& a, int lane, int gw, int NGW) {
    const bf16_t* gb = (const bf16_t*)(a.ws + WS_G); bf16_t* ub = (bf16_t*)(a.ws + WS_U);
    const float* cw = a.in[24]; const float* cb = a.in[25];
    for (int it = gw; it < NB * 16 * 8 * 12; it += NGW) {
        const int cbk = it % 12; int r = it / 12; const int co = r & 7; r >>= 3; const int rp = r & 15; const int b = r >> 4;
        const int ch = cbk * 256 + lane * 4, r0 = rp * 2, c0 = co * 8;
        u32x2 gin[4][10], uin[2][8];
#pragma unroll
        for (int ir = 0; ir < 4; ++ir)
#pragma unroll
            for (int ci = 0; ci < 10; ++ci) { const int rr = r0 - 1 + ir, cc = c0 - 1 + ci;
                gin[ir][ci] = (u32x2){0u, 0u};
                if (rr >= 0 && rr < 32 && cc >= 0 && cc < 64) gin[ir][ci] = *(const u32x2*)(gb + (size_t)(b * SEQL + rr * 64 + cc) * DFF + ch); }
#pragma unroll
        for (int o = 0; o < 2; ++o)
#pragma unroll
            for (int oc = 0; oc < 8; ++oc) uin[o][oc] = *(const u32x2*)(ub + (size_t)(b * SEQL + (r0 + o) * 64 + c0 + oc) * DFF + ch);
        f32x4 w[9];
#pragma unroll
        for (int k = 0; k < 9; ++k) w[k] = *(const f32x4*)(cw + k * DFF + ch);
        const f32x4 bias = *(const f32x4*)(cb + ch);
#pragma unroll
        for (int oc = 0; oc < 8; ++oc)
#pragma unroll
            for (int o = 0; o < 2; ++o) {
                f32x4 acc = bias;
#pragma unroll
                for (int ky = 0; ky < 3; ++ky)
#pragma unroll
                    for (int kx = 0; kx < 3; ++kx) { const u32x2 gv = gin[o + ky][oc + kx];
                        acc += (f32x4){bf_lo(gv.x), bf_hi(gv.x), bf_lo(gv.y), bf_hi(gv.y)} * w[ky * 3 + kx]; }
                const u32x2 uv = uin[o][oc];
                u32x2 ov; ov.x = cvt_pk_bf16(gelu_f(acc.x) * bf_lo(uv.x), gelu_f(acc.y) * bf_hi(uv.x)); ov.y = cvt_pk_bf16(gelu_f(acc.z) * bf_lo(uv.y), gelu_f(acc.w) * bf_hi(uv.y));
                *(u32x2*)(ub + (size_t)(b * SEQL + (r0 + o) * 64 + c0 + oc) * DFF + ch) = ov;
            }
    }
}

__global__ void __launch_bounds__(512, 2) mk_fwd(Args a) {
    extern __shared__ __attribute__((aligned(16))) unsigned char lds_raw[];
    LAS unsigned char* lds = (LAS unsigned char*)lds_raw;
    const int tid = threadIdx.x, lane = tid & 63, wave = __builtin_amdgcn_readfirstlane(tid >> 6);
    const int G = gridDim.x, gw = blockIdx.x * 8 + wave, NGW = G * 8;
    unsigned char* ws = a.ws;
    const int lo = a.ph_lo, hi = a.ph_hi;
#define IN(k) (lo <= (k) && (k) < hi)
#if MK_ONE
    cg::grid_group grid = cg::this_grid();
    if (hi > NPHASE) grid.sync();
    volatile LAS unsigned* misc = (volatile LAS unsigned*)(lds + MISC_OFF);
    if (tid < 16) misc[tid] = 0u;
    __syncthreads();
    const XcdBarrier bar = xcd_barrier_post((unsigned*)ws, misc);
#define SEAM(k) do { if (IN(k) && IN((k) + 1)) xcd_barrier(bar); } while (0)
#define REPBAR(r) do { if (r) xcd_barrier(bar); } while (0)
#else
#define SEAM(k) do { } while (0)
#define REPBAR(r) do { } while (0)
#endif
    using namespace pg8;

    for (int rep = 0; IN(0) && rep < 1 + ((MK_REP >> 0) & 1); ++rep) { REPBAR(rep); p0_prep(a, lds, tid, lane, wave, G); }
    SEAM(0);
    for (int rep = 0; IN(1) && rep < 1 + ((MK_REP >> 1) & 1); ++rep) { REPBAR(rep); p1_norm1(a, lane, gw, NGW); }
    SEAM(1);
    for (int rep = 0; IN(2) && rep < 1 + ((MK_REP >> 2) & 1); ++rep) { REPBAR(rep);
        Gemm g{(const bf16_t*)(ws + WS_HX), (const bf16_t*)(ws + WS_WIN), MT, DIN, D}; Order1 S{G, (int)blockIdx.x};
        Epi1 E{(bf16_t*)(ws + WS_UPOOL), (bf16_t*)(ws + WS_ULRU), (bf16_t*)(ws + WS_GG), (bf16_t*)(ws + WS_SGP), (bf16_t*)(ws + WS_SGL), (bf16_t*)(ws + WS_CTXP)};
        gemm_phase<Epi1, Order1, true, true>(lds, g, S, E);
    }
    SEAM(2);
    for (int rep = 0; IN(3) && rep < 1 + ((MK_REP >> 3) & 1); ++rep) { REPBAR(rep);
        p3_pool(a, lds, tid, G);
        for (int it = blockIdx.x; it < NB * NCHUNK * 8; it += G) { const int nb = it & 7, r = it >> 3; lru_item<false>(a, lds, r / NCHUNK, r % NCHUNK, nb, tid, lane, wave); }
    }
    SEAM(3);
    for (int rep = 0; IN(4) && rep < 1 + ((MK_REP >> 4) & 1); ++rep) { REPBAR(rep);
        for (int it = blockIdx.x; it < NB * 16 * 8; it += G) { const int nb = it & 7, r = it >> 3; lru_item<true>(a, lds, r >> 4, 2 + (r & 15), nb, tid, lane, wave); }
    }
    SEAM(4);
    for (int rep = 0; IN(5) && rep < 1 + ((MK_REP >> 5) & 1); ++rep) { REPBAR(rep);
        { Gemm g{(const bf16_t*)(ws + WS_DP), (const bf16_t*)(ws + WS_WPP), M, D, D}; StaticOrder S; S.init(M, D, G, (int)blockIdx.x, D);
          Epi2<false> E{(const bf16_t*)(ws + WS_SGP), (bf16_t*)(ws + WS_T1M)};
          gemm_phase<Epi2<false>, StaticOrder, false, true>(lds, g, S, E); }
        { Gemm g{(const bf16_t*)(ws + WS_YLRU), (const bf16_t*)(ws + WS_WLP), M, D, D}; StaticOrder S; S.init(M, D, G, (int)blockIdx.x, D);
          Epi2<true> E{(const bf16_t*)(ws + WS_SGL), (bf16_t*)(ws + WS_T1M)};
          gemm_phase<Epi2<true>, StaticOrder, false, true>(lds, g, S, E); }
    }
    SEAM(5);
    for (int rep = 0; IN(6) && rep < 1 + ((MK_REP >> 6) & 1); ++rep) { REPBAR(rep);
        Gemm g{(const bf16_t*)(ws + WS_T1M), (const bf16_t*)(ws + WS_WOUT), M, D, D}; StaticOrder S; S.init(M, D, G, (int)blockIdx.x, D);
        EpiBf16 E{(bf16_t*)(ws + WS_MIX), D};
        gemm_phase<EpiBf16, StaticOrder, false, true>(lds, g, S, E);
    }
    SEAM(6);
    for (int rep = 0; IN(7) && rep < 1 + ((MK_REP >> 7) & 1); ++rep) { REPBAR(rep); p8_norm2(a, (int)__builtin_amdgcn_mbcnt_hi(~0u, __builtin_amdgcn_mbcnt_lo(~0u, 0u)), gw, NGW); }
    SEAM(7);
    for (int rep = 0; IN(8) && rep < 1 + ((MK_REP >> 8) & 1); ++rep) { REPBAR(rep);
        Gemm g{(const bf16_t*)(ws + WS_H2), (const bf16_t*)(ws + WS_WUP), M, 2 * DFF, D}; StaticOrder S; S.init(M, 2 * DFF, G, (int)blockIdx.x, D);
        Epi4 E{(bf16_t*)(ws + WS_G), (bf16_t*)(ws + WS_U)};
        gemm_phase<Epi4, StaticOrder, true, true>(lds, g, S, E);
    }
    SEAM(8);
    for (int rep = 0; IN(9) && rep < 1 + ((MK_REP >> 9) & 1); ++rep) { REPBAR(rep); p10_conv(a, (int)__builtin_amdgcn_mbcnt_hi(~0u, __builtin_amdgcn_mbcnt_lo(~0u, 0u)), gw, NGW); }
    SEAM(9);
    for (int rep = 0; IN(10) && rep < 1 + ((MK_REP >> 10) & 1); ++rep) { REPBAR(rep);
        Gemm g{(const bf16_t*)(ws + WS_U), (const bf16_t*)(ws + WS_WDOWN), M, D, DFF}; StaticOrder S; S.init(M, D, G, (int)blockIdx.x, DFF);
        EpiBf16 E{(bf16_t*)(ws + WS_FX), D};
        gemm_phase<EpiBf16, StaticOrder, false, true>(lds, g, S, E);
    }
    SEAM(10);
    for (int rep = 0; IN(11) && rep < 1 + ((MK_REP >> 11) & 1); ++rep) { REPBAR(rep); p12_final(a, (int)__builtin_amdgcn_mbcnt_hi(~0u, __builtin_amdgcn_mbcnt_lo(~0u, 0u)), gw, NGW); }
#undef IN
#undef SEAM
#undef REPBAR
}

extern "C" void kernel_launch(void* const* d_in, const int* in_sizes, int n_in, void* d_out, int out_size, void* d_ws, size_t ws_size, hipStream_t stream) {
    static int grid = 0;
    if (grid == 0) {
        if (n_in != 27 || in_sizes[0] != M * D || out_size != M * D || ws_size < WS_END) { fprintf(stderr, "kernel_launch: unexpected shapes (n_in %d, in0 %d, out %d, ws %zu)\n", n_in, n_in > 0 ? in_sizes[0] : -1, out_size, ws_size); grid = -1; return; }
        int dev = 0, cus = 0, per_cu = 0;
        if (hipGetDevice(&dev) != hipSuccess || hipDeviceGetAttribute(&cus, hipDeviceAttributeMultiprocessorCount, dev) != hipSuccess) { grid = -1; return; }
        if (hipFuncSetAttribute((const void*)mk_fwd, hipFuncAttributeMaxDynamicSharedMemorySize, LDS_BYTES) != hipSuccess) { fprintf(stderr, "kernel_launch: hipFuncSetAttribute failed\n"); grid = -1; return; }
        if (hipOccupancyMaxActiveBlocksPerMultiprocessor(&per_cu, (const void*)mk_fwd, 512, LDS_BYTES) != hipSuccess || per_cu < 1) { fprintf(stderr, "kernel_launch: occupancy query says %d\n", per_cu); per_cu = 1; }
        (void)hipGetLastError();
        grid = cus * 1;
    }
    if (grid < 0) return;
    Args a{};
    for (int i = 0; i < 27; ++i) a.in[i] = (const float*)d_in[i];
    a.out = (float*)d_out; a.ws = (unsigned char*)d_ws;
#if MK_ONE
    a.ph_lo = 0; a.ph_hi = NPHASE;
    if (hipMemsetAsync(d_ws, 0, CTL_BYTES, stream) != hipSuccess) { fprintf(stderr, "kernel_launch: memset of the barrier words failed\n"); return; }
    void* kargs[] = {&a};
    hipError_t e = hipLaunchCooperativeKernel((const void*)mk_fwd, dim3(grid), dim3(512), kargs, LDS_BYTES, stream);
    if (e != hipSuccess) fprintf(stderr, "cooperative launch failed: %s (grid %d)\n", hipGetErrorString(e), grid);
#else
    for (int p = 0; p < NPHASE; ++p) {
        a.ph_lo = p; a.ph_hi = p + 1;
        hipLaunchKernelGGL(mk_fwd, dim3(grid), dim3(512), LDS_BYTES, stream, a);
    }
#endif
}
```
